# Optimizing an MI355X kernel written in HIP

```python
import jax, jax.numpy as jnp
from jax import lax
import numpy as np

D_MODEL = 2048
BATCH = 4
SEQ = 2048
DEPTH = 4

CHUNK = 64
N_PREV_CHUNKS = 8
N_BAND = N_PREV_CHUNKS + 1
A_HEADS = 8
A_HEAD_DIM = 128
A_WIDTH = A_HEADS * A_HEAD_DIM
REL_CLIP = 256
R_HEADS = 8
R_HEAD_DIM = 128
R_WIDTH = R_HEADS * R_HEAD_DIM
ROPE_BASE = 10000.0
N_BRANCH = 2
D_FF = 5632
CONV_W = 3
EPS = 1e-6

IN_SIZES = (A_WIDTH, A_WIDTH, A_WIDTH,
            R_WIDTH, R_WIDTH, R_WIDTH, R_WIDTH,
            N_BRANCH * D_MODEL)
D_IN = sum(IN_SIZES)
IN_SPLITS = [int(s) for s in np.cumsum(IN_SIZES)[:-1]]

kernel_name = "hybrid_chunked_attn_retention_convffn"


def rmsnorm(x, g):
    xf = x.astype(jnp.float32)
    y = xf * lax.rsqrt(jnp.mean(xf * xf, axis=-1, keepdims=True) + EPS)
    return (y * g.astype(jnp.float32)).astype(x.dtype)


def rotary(x):
    _, s, _, d = x.shape
    half = d // 2
    inv = ROPE_BASE ** (-jnp.arange(half, dtype=jnp.float32) / half)
    ang = jnp.arange(s, dtype=jnp.float32)[:, None] * inv[None, :]
    cos = jnp.cos(ang)[None, :, None, :]
    sin = jnp.sin(ang)[None, :, None, :]
    xf = x.astype(jnp.float32)
    x1, x2 = xf[..., :half], xf[..., half:]
    return jnp.concatenate([x1 * cos - x2 * sin, x1 * sin + x2 * cos], axis=-1).astype(x.dtype)


def chunked_band_attention(q, k, v, rel_bias):
    b, s, h, hd = q.shape
    nc = s // CHUNK
    qc = q.reshape(b, nc, CHUNK, h, hd)
    pad = ((0, 0), (N_PREV_CHUNKS, 0), (0, 0), (0, 0), (0, 0))
    kp = jnp.pad(k.reshape(b, nc, CHUNK, h, hd), pad)
    vp = jnp.pad(v.reshape(b, nc, CHUNK, h, hd), pad)
    scale = hd ** -0.5
    scores = jnp.stack(
        [jnp.einsum('bcqhd,bckhd->bhcqk', qc, kp[:, j:j + nc]) for j in range(N_BAND)],
        axis=4).astype(jnp.float32) * scale
    i_idx = np.arange(CHUNK)[:, None, None]
    j_idx = np.arange(N_BAND)[None, :, None]
    l_idx = np.arange(CHUNK)[None, None, :]
    dist = (N_PREV_CHUNKS - j_idx) * CHUNK + i_idx - l_idx
    idx = np.clip(dist, -REL_CLIP, REL_CLIP) + REL_CLIP
    bias = rel_bias[:, idx].astype(jnp.float32)
    scores = scores + bias[None, :, None]
    valid = (jnp.arange(nc)[:, None] - N_PREV_CHUNKS + jnp.arange(N_BAND)[None, :]) >= 0
    scores = jnp.where(valid[None, None, :, None, :, None], scores, -jnp.inf)
    p = jax.nn.softmax(scores.reshape(b, h, nc, CHUNK, N_BAND * CHUNK), axis=-1)
    p = p.reshape(b, h, nc, CHUNK, N_BAND, CHUNK).astype(v.dtype)
    out = jnp.einsum('bhcqk,bckhd->bcqhd', p[:, :, :, :, 0], vp[:, 0:nc])
    for j in range(1, N_BAND):
        out = out + jnp.einsum('bhcqk,bckhd->bcqhd', p[:, :, :, :, j], vp[:, j:j + nc])
    return out.reshape(b, s, h * hd)


def retention(q, k, v):
    b, s, h, d = q.shape
    nc = s // CHUNK
    f32 = jnp.float32
    qc = q.astype(f32).reshape(b, nc, CHUNK, h, d)
    kc = (k.astype(f32) * d ** -0.5).reshape(b, nc, CHUNK, h, d)
    vc = v.astype(f32).reshape(b, nc, CHUNK, h, d)
    lg = jnp.log1p(-jnp.exp2(-5.0 - jnp.arange(h, dtype=f32)))
    n = jnp.arange(CHUNK, dtype=f32)
    diff = n[:, None] - n[None, :]
    dmat = jnp.where(diff >= 0, jnp.exp(lg[:, None, None] * jnp.maximum(diff, 0.0)), 0.0)
    inner = jnp.einsum('bcnhd,bcmhd->bhcnm', qc, kc) * dmat[None, :, None]
    y_in = jnp.einsum('bhcnm,bcmhe->bcnhe', inner, vc)
    zeta = jnp.exp(lg[:, None] * (CHUNK - 1 - n)[None, :])
    kv = jnp.einsum('bcmhd,bcmhe,hm->cbhde', kc, vc, zeta)
    chunk_decay = jnp.exp(lg * CHUNK)[None, :, None, None]

    def step(state, kv_c):
        return state * chunk_decay + kv_c, state

    _, r_prev = lax.scan(step, jnp.zeros((b, h, d, d), f32), kv)
    xi = jnp.exp(lg[:, None] * (n + 1.0)[None, :])
    y_x = jnp.einsum('bcnhd,cbhde,hn->bcnhe', qc, r_prev, xi)
    return (y_in + y_x).reshape(b, s, h, d).astype(q.dtype)


def causal_depthwise_conv(u, w, bias):
    s = u.shape[1]
    up = jnp.pad(u, ((0, 0), (CONV_W - 1, 0), (0, 0)))
    out = bias
    for t in range(CONV_W):
        out = out + w[t] * up[:, t:t + s]
    return out


def setup_inputs(seed: int = 0) -> dict:
    key = jax.random.key(seed)
    ks = jax.random.split(key, 16)
    f32 = jnp.float32
    nrm = lambda k, shape, sc: jax.random.normal(k, shape, f32) * sc
    return {
        "x": nrm(ks[0], (BATCH, SEQ, D_MODEL), 1.0),
        "w_in": nrm(ks[1], (DEPTH, D_MODEL, D_IN), D_MODEL ** -0.5),
        "w_br": nrm(ks[2], (DEPTH, N_BRANCH, A_WIDTH, D_MODEL), A_WIDTH ** -0.5),
        "w_o": nrm(ks[3], (DEPTH, D_MODEL, D_MODEL), D_MODEL ** -0.5),
        "mix_norm": 1.0 + nrm(ks[4], (DEPTH, D_MODEL), 0.02),
        "q_gain": 1.0 + nrm(ks[5], (DEPTH, A_HEAD_DIM), 0.02),
        "k_gain": 1.0 + nrm(ks[6], (DEPTH, A_HEAD_DIM), 0.02),
        "rel_bias": nrm(ks[7], (A_HEADS, 2 * REL_CLIP + 1), 0.5),
        "r_gain": 1.0 + nrm(ks[8], (DEPTH, R_HEAD_DIM), 0.02),
        "ffn_norm": 1.0 + nrm(ks[9], (DEPTH, D_MODEL), 0.02),
        "w_up": nrm(ks[10], (DEPTH, D_MODEL, 2 * D_FF), D_MODEL ** -0.5),
        "conv_w": nrm(ks[11], (DEPTH, CONV_W, 2 * D_FF), CONV_W ** -0.5),
        "conv_b": nrm(ks[12], (DEPTH, 2 * D_FF), 0.01),
        "w_down": nrm(ks[13], (DEPTH, D_FF, D_MODEL), D_FF ** -0.5),
    }


def reference(x, w_in, w_br, w_o, mix_norm, q_gain, k_gain, rel_bias, r_gain,
              ffn_norm, w_up, conv_w, conv_b, w_down):
    b, s, _ = x.shape
    for l in range(DEPTH):
        h = rmsnorm(x, mix_norm[l])
        z = h @ w_in[l]
        aq, ak, av, rq, rk, rv, rg, gl = jnp.split(z, IN_SPLITS, axis=-1)
        aq = rmsnorm(aq.reshape(b, s, A_HEADS, A_HEAD_DIM), q_gain[l])
        ak = rmsnorm(ak.reshape(b, s, A_HEADS, A_HEAD_DIM), k_gain[l])
        av = av.reshape(b, s, A_HEADS, A_HEAD_DIM)
        ya = chunked_band_attention(aq, ak, av, rel_bias)
        rq = rotary(rq.reshape(b, s, R_HEADS, R_HEAD_DIM))
        rk = rotary(rk.reshape(b, s, R_HEADS, R_HEAD_DIM))
        rv = rv.reshape(b, s, R_HEADS, R_HEAD_DIM)
        yr = rmsnorm(retention(rq, rk, rv), r_gain[l]).reshape(b, s, R_WIDTH)
        yr = jax.nn.silu(rg) * yr
        gates = jax.nn.sigmoid(gl.reshape(b, s, N_BRANCH, D_MODEL))
        merged = gates[:, :, 0] * (ya @ w_br[l, 0]) + gates[:, :, 1] * (yr @ w_br[l, 1])
        x = x + merged @ w_o[l]
        h = rmsnorm(x, ffn_norm[l])
        u = causal_depthwise_conv(h @ w_up[l], conv_w[l], conv_b[l])
        ua, ub = jnp.split(u, 2, axis=-1)
        x = x + (jax.nn.gelu(ua, approximate=False) * ub) @ w_down[l]
    return x
```

```cpp
#include <hip/hip_runtime.h>
#include <cstdio>
#include <cstdint>
#include <type_traits>
namespace pg8 {
#define PG8_LAS __attribute__((address_space(3)))
typedef unsigned short bf16_t;
typedef short bf16x8 __attribute__((ext_vector_type(8)));
typedef float f32x4 __attribute__((ext_vector_type(4)));
typedef unsigned u32x4 __attribute__((ext_vector_type(4)));
constexpr int BM = 256, BK = 64, HALF = 128, HTB = HALF * BK * 2  , STAGE_BYTES = 8 * HTB, NXCD = 8, WGM = 8;

__host__ __device__ __forceinline__ int lds_byte(int r, int c) { const int st = (r >> 4) * 2 + (c >> 5), rr = r & 15, cc = c & 31, ob = rr * 64 + cc * 2; return st * 1024 + (ob ^ (((ob >> 9) & 1) << 5)); }
__host__ __device__ __forceinline__ void stage_rc(int b, int& R, int& C) { const int st = b / 1024, sb = b % 1024, swz = sb ^ (((sb >> 9) & 1) << 5); R = (st >> 1) * 16 + swz / 64; C = (st & 1) * 32 + (swz % 64) / 2; }
__host__ __device__ __forceinline__ int perm32(int rho) { const int n = rho >> 4, i = rho & 15; return 8 * (i >> 2) + 4 * n + (i & 3); }

struct Unit { int pm, pn; };
struct Gemm { const bf16_t* A; const bf16_t* Bt; int M, N, K, a_rows, wave_s; };

struct StaticOrder {
    int nM, nN, nwg, G, c;
    __host__ __device__ void init(int M, int N, int G_, int c_) { nM = M / BM; nN = N / BM; nwg = nM * nN; G = G_; c = c_; }
    __host__ __device__ __forceinline__ bool next(int i, Unit& u) const {
        const long L = (long)i * G + c; if (L >= nwg) return false;
        int wgid = (int)L; { const int q = nwg / NXCD, r = nwg % NXCD, xcd = wgid % NXCD, off = wgid / NXCD; wgid = (xcd < r ? xcd * (q + 1) : r * (q + 1) + (xcd - r) * q) + off; }
        const int nig = WGM * nN, gid = wgid / nig, fm = gid * WGM, gsz = (nM - fm) < WGM ? (nM - fm) : WGM;
        u.pm = fm + ((wgid % nig) % gsz); u.pn = (wgid % nig) / gsz; return true;
    }
    __device__ __forceinline__ void a_ready(const Unit&) const {}
    __device__ __forceinline__ void done(const Unit&) const {}
};
struct DealOrder {
    StaticOrder so; int nv, kv, R;
    __device__ __forceinline__ void init(int M, int N, int G, int c, int nv_, int kv_) { so.init(M, N, G, c); nv = nv_; kv = kv_; const int nonv = G - nv_; R = (so.nwg - nv_ * kv_ + nonv - 1) / nonv;
        const int left = (R - 1 - kv_) * nv_ + (so.nwg - (R - 1) * G);
        if (nv_ <= 0 || R - 1 < kv_ || (long)(R - 1) * G > so.nwg || left > nonv) { nv = 0; kv = 0; R = (so.nwg + G - 1) / G; } }
    __device__ __forceinline__ bool at(long L, Unit& u) const { if (L >= so.nwg) return false; StaticOrder t = so; t.c = 0; t.G = 1; return t.next((int)L, u); }
    __device__ __forceinline__ bool next(int i, Unit& u) const {
        if (!nv) return so.next(i, u);
        const int G = so.G, c = so.c, nonv = G - nv;
        if (c >= nonv) return i < kv && at((long)i * G + c, u);
        if (i < R - 1) return at((long)i * G + c, u);
        if (i > R - 1) return false;
        const int nfree = (R - 1 - kv) * nv;
        return c < nfree ? at((long)(kv + c / nv) * G + nonv + c % nv, u) : at((long)(R - 1) * G + (c - nfree), u);
    }
    __device__ __forceinline__ bool converts() const { return nv && so.c >= so.G - nv; }
    __device__ __forceinline__ void a_ready(const Unit&) const {}
    __device__ __forceinline__ void done(const Unit&) const {}
};
struct XcdDeal {
    StaticOrder so; int R, G8, nlong, base, conv_rank, nconv, j;
    __device__ __forceinline__ void init(int M, int N, int G, int c) { so.init(M, N, G, c); G8 = G / 8; R = (so.nwg + G - 1) / G; const int full = so.nwg - (R - 1) * G;
        const int x = c % 8; j = c / 8; base = 0; int crank = 0;
        for (int y = 0; y < x; ++y) { int ly = full - G8 * y; ly = ly < 0 ? 0 : ly > G8 ? G8 : ly; base += (R - 1) * G8 + ly; crank += G8 - ly; }
        nlong = full - G8 * x; nlong = nlong < 0 ? 0 : nlong > G8 ? G8 : nlong; conv_rank = j >= nlong ? crank + (j - nlong) : -1; nconv = G - full; }
    __device__ __forceinline__ bool next(int i, Unit& u) const {
        if (i >= (j < nlong ? R : R - 1)) return false;
        const int wgid = base + i * G8 + j; if (wgid >= so.nwg) return false;
        const int nig = WGM * so.nN, gid = wgid / nig, fm = gid * WGM, gsz = (so.nM - fm) < WGM ? (so.nM - fm) : WGM;
        u.pm = fm + ((wgid % nig) % gsz); u.pn = (wgid % nig) / gsz; return true;
    }
};
struct ListOrder {
    PG8_LAS const int* tab;
    __device__ __forceinline__ bool next(int i, Unit& u) const { if (i >= 8) return false; const int pm = __builtin_amdgcn_readfirstlane(tab[2 * i]); if (pm < 0) return false; u.pm = pm; u.pn = __builtin_amdgcn_readfirstlane(tab[2 * i + 1]); return true; }
    __device__ __forceinline__ void a_ready(const Unit&) const {}
    __device__ __forceinline__ void done(const Unit&) const {}
};
#define GAS __attribute__((address_space(1)))
__device__ __forceinline__ unsigned cvt_pk_bf16(float lo, float hi) { unsigned r; asm volatile("v_cvt_pk_bf16_f32 %0, %1, %2" : "=v"(r) : "v"(lo), "v"(hi)); return r; }
typedef float f32x2 __attribute__((ext_vector_type(2)));
typedef unsigned u32x2 __attribute__((ext_vector_type(2)));
__device__ __forceinline__ f32x4 bf_lo4(u32x4 w) { return (f32x4){__uint_as_float(w.x << 16), __uint_as_float(w.x & 0xffff0000u), __uint_as_float(w.y << 16), __uint_as_float(w.y & 0xffff0000u)}; }
__device__ __forceinline__ f32x4 bf_hi4(u32x4 w) { return (f32x4){__uint_as_float(w.z << 16), __uint_as_float(w.z & 0xffff0000u), __uint_as_float(w.w << 16), __uint_as_float(w.w & 0xffff0000u)}; }
__device__ __forceinline__ u32x4 pack8(f32x4 a, f32x4 b) { u32x4 w; w.x = cvt_pk_bf16(a[0], a[1]); w.y = cvt_pk_bf16(a[2], a[3]); w.z = cvt_pk_bf16(b[0], b[1]); w.w = cvt_pk_bf16(b[2], b[3]); return w; }
__device__ __forceinline__ u32x2 pack4(f32x4 a) { u32x2 w; w.x = cvt_pk_bf16(a[0], a[1]); w.y = cvt_pk_bf16(a[2], a[3]); return w; }
__device__ __forceinline__ f32x2 gelu_pk(f32x2 v) {
    const f32x2 av = __builtin_elementwise_abs(v);
    f32x2 c; c.x = __builtin_fminf(av.x, 6.0f); c.y = __builtin_fminf(av.y, 6.0f);
    const f32x2 t = c * 0.3333333433f + (-1.0f);
    f32x2 q = t * 4.012244033e-05f + (-4.253455538e-03f); q = q * t + 1.670462410e-02f; q = q * t + (-4.057419415e-02f); q = q * t + 9.177813536e-02f;
    q = q * t + (-2.040495559e-01f); q = q * t + (-6.034001065e+00f); q = q * t + (-1.420954958e+01f); q = q * t + (-9.532934732e+00f);
    f32x2 T; T.x = __builtin_amdgcn_exp2f(q.x); T.y = __builtin_amdgcn_exp2f(q.y);
    const f32x2 h = 0.5f - T;
    return av * h + v * 0.5f;
}
__device__ __forceinline__ float sigmoidf_(float x) { return __builtin_amdgcn_rcpf(1.0f + __builtin_amdgcn_exp2f(-1.4426950408889634f * x)); }

#ifndef NT_STORES
#define NT_STORES 0
#endif
#if NT_STORES
#define ST_BIG(p, v) __builtin_nontemporal_store((v), (p))
#else
#define ST_BIG(p, v) (*(p) = (v))
#endif
__device__ __forceinline__ float lg2_gamma(int h) { const float e = __builtin_ldexpf(1.0f, -5 - h);
    return -1.4426950408889634f * e * (1.0f + e * (0.5f + e * (0.3333333333f + e * (0.25f + e * (0.2f + e * 0.1666666667f))))); }
constexpr size_t ZSEC = (size_t)8192 * 1024;
struct Epi1 {
    static constexpr bool PERM = true, AFTER_DRAIN = false, ROWSCALE = true;
    PG8_LAS const float* rs; bf16_t* ZB; const float* qg; const float* kg; const float* cs; PG8_LAS float* xch;
    __device__ __forceinline__ void operator()(const f32x4 (&acc)[2][2][4][2], const Unit& u, int wr, int wc, int fr, int fq) const {
        const int sec = u.pn >> 2; const int rowl0 = wr * 64 + fr; const size_t LD = 1024;
        bf16_t* zb0 = ZB + (size_t)sec * ZSEC + (size_t)(u.pm * BM + rowl0) * LD + (u.pn & 3) * BM + wc * 32 + 8 * fq;
        if (sec <= 1) {
#pragma unroll
            for (int ai = 0; ai < 2; ++ai)
#pragma unroll
                for (int m = 0; m < 4; ++m)
#pragma unroll
                    for (int bj = 0; bj < 2; ++bj) { const f32x4 a = acc[ai][bj][m][0], b = acc[ai][bj][m][1];
                        float s = (a[0] * a[0] + a[1] * a[1]) + (a[2] * a[2] + a[3] * a[3]) + (b[0] * b[0] + b[1] * b[1]) + (b[2] * b[2] + b[3] * b[3]);
                        { auto r16 = __builtin_amdgcn_permlane16_swap(__float_as_uint(s), __float_as_uint(s), false, false); s = __uint_as_float(r16[0]) + __uint_as_float(r16[1]); auto r32 = __builtin_amdgcn_permlane32_swap(__float_as_uint(s), __float_as_uint(s), false, false); s = __uint_as_float(r32[0]) + __uint_as_float(r32[1]); }
                        if (fq == 0) xch[((ai * HALF + rowl0 + m * 16) * 2 + bj) * 4 + wc] = s; }
            asm volatile("s_waitcnt lgkmcnt(0)" ::: "memory"); __builtin_amdgcn_s_barrier(); asm volatile("" ::: "memory");
            const float* g = (sec == 0 ? qg : kg) + wc * 32 + 8 * fq; const float gs = sec == 0 ? 0.08838834764831845f * 1.4426950408889634f : 1.0f;
            const f32x4 g0 = *(const f32x4*)g * gs, g1 = *(const f32x4*)(g + 4) * gs;
#pragma unroll
            for (int ai = 0; ai < 2; ++ai)
#pragma unroll
                for (int m = 0; m < 4; ++m)
#pragma unroll
                    for (int bj = 0; bj < 2; ++bj) { const f32x4 p = *(const PG8_LAS f32x4*)(xch + ((ai * HALF + rowl0 + m * 16) * 2 + bj) * 4);
                        const float r = 1.0f / sqrtf(((p[0] + p[1]) + (p[2] + p[3])) * (1.0f / 128.0f) + 1e-6f);
                        ST_BIG((u32x4*)(zb0 + (size_t)(ai * HALF + m * 16) * LD + bj * HALF), pack8(acc[ai][bj][m][0] * r * g0, acc[ai][bj][m][1] * r * g1)); }
        } else if (sec == 3 || sec == 4) {
            const int hd = wc >> 1, i0 = 32 * (wc & 1) + 8 * fq; bf16_t* zr0 = ZB + (size_t)sec * ZSEC + (size_t)(u.pm * BM + rowl0) * LD + (u.pn & 3) * BM + hd * 128 + i0;
            const float lg2 = lg2_gamma((u.pn & 3) * 2 + hd);
#pragma unroll
            for (int ai = 0; ai < 2; ++ai) {
                f32x4 ct[4][4];
#pragma unroll
                for (int m = 0; m < 4; ++m) { const int pos = (u.pm * BM + rowl0 + ai * HALF + m * 16) & 2047; const float* cp = cs + (size_t)pos * 128 + 2 * i0;
#pragma unroll
                    for (int k = 0; k < 4; ++k) ct[m][k] = *(const f32x4*)(cp + 4 * k); }
                __builtin_amdgcn_sched_barrier(0);
#pragma unroll
                for (int m = 0; m < 4; ++m) { const int pos = (u.pm * BM + rowl0 + ai * HALF + m * 16) & 2047;
                    const f32x4 c0 = ct[m][0], c1 = ct[m][1], c2 = ct[m][2], c3 = ct[m][3];
                    const f32x4 cva = (f32x4){c0[0], c0[2], c1[0], c1[2]}, sva = (f32x4){c0[1], c0[3], c1[1], c1[3]}, cvb = (f32x4){c2[0], c2[2], c3[0], c3[2]}, svb = (f32x4){c2[1], c2[3], c3[1], c3[3]};
                    const float sc = sec == 3 ? __builtin_amdgcn_exp2f(lg2 * (float)(pos & 63)) : 0.08838834764831845f * __builtin_amdgcn_exp2f(-lg2 * (float)(pos & 63));
                    const f32x4 x1a = acc[ai][0][m][0], x1b = acc[ai][0][m][1], x2a = acc[ai][1][m][0], x2b = acc[ai][1][m][1];
                    bf16_t* o = zr0 + (size_t)(ai * HALF + m * 16) * LD;
                    ST_BIG((u32x4*)o, pack8((x1a * cva - x2a * sva) * sc, (x1b * cvb - x2b * svb) * sc)); ST_BIG((u32x4*)(o + 64), pack8((x1a * sva + x2a * cva) * sc, (x1b * svb + x2b * cvb) * sc)); }
                __builtin_amdgcn_sched_barrier(0);
            }
        } else {
#pragma unroll
            for (int ai = 0; ai < 2; ++ai)
#pragma unroll
                for (int m = 0; m < 4; ++m)
#pragma unroll
                    for (int bj = 0; bj < 2; ++bj) { f32x4 a = acc[ai][bj][m][0], b = acc[ai][bj][m][1];
                        if (sec >= 6) {
#pragma unroll
                            for (int j = 0; j < 4; ++j) { const float sa = sigmoidf_(a[j]), sb = sigmoidf_(b[j]); a[j] = sec == 6 ? a[j] * sa : sa; b[j] = sec == 6 ? b[j] * sb : sb; } }
                        ST_BIG((u32x4*)(zb0 + (size_t)(ai * HALF + m * 16) * LD + bj * HALF), pack8(a, b)); }
        }
    }
};

struct EpiBr {
    static constexpr bool PERM = true, AFTER_DRAIN = false, ROWSCALE = false;
    const bf16_t* ZB; bf16_t* MRG;
    template <int BR> __device__ __forceinline__ void run(const f32x4 (&acc)[2][2][4][2], int row0, int col0) const {
        const size_t LD = 1024;
        u32x4 gw[2][2][2], tw[2][2][2];
#define EBR_LOAD(q, B) do { _Pragma("unroll") for (int mm = 0; mm < 2; ++mm) _Pragma("unroll") for (int bj = 0; bj < 2; ++bj) { \
            const size_t row = (size_t)(row0 + ((q) >> 1) * HALF + (2 * ((q) & 1) + mm) * 16); const int col = col0 + bj * HALF; \
            gw[B][mm][bj] = *(const u32x4*)(ZB + (size_t)(7 + 2 * BR + (col >> 10)) * ZSEC + row * LD + (col & 1023)); \
            if (BR) tw[B][mm][bj] = *(const u32x4*)(MRG + row * 2048 + col); } } while (0)
        EBR_LOAD(0, 0);
#pragma unroll
        for (int q = 0; q < 4; ++q) { const int B = q & 1;
            if (q < 3) { if (B) EBR_LOAD(q + 1, 0); else EBR_LOAD(q + 1, 1); }
            __builtin_amdgcn_sched_barrier(0);
#pragma unroll
            for (int mm = 0; mm < 2; ++mm)
#pragma unroll
                for (int bj = 0; bj < 2; ++bj) { const int ai = q >> 1, m = 2 * (q & 1) + mm; const size_t row = (size_t)(row0 + ai * HALF + m * 16); const int col = col0 + bj * HALF;
                    const f32x4 a = acc[ai][bj][m][0] * bf_lo4(gw[B][mm][bj]), b = acc[ai][bj][m][1] * bf_hi4(gw[B][mm][bj]);
                    bf16_t* t = MRG + row * 2048 + col;
                    if (BR == 0) *(u32x4*)t = pack8(a, b);
                    else *(u32x4*)t = pack8(bf_lo4(tw[B][mm][bj]) + a, bf_hi4(tw[B][mm][bj]) + b); }
            __builtin_amdgcn_sched_barrier(0);
        }
#undef EBR_LOAD
    }
    __device__ __forceinline__ void operator()(const f32x4 (&acc)[2][2][4][2], const Unit& u, int wr, int wc, int fr, int fq) const {
        const int br = u.pm >> 5, pm = u.pm & 31, pn = u.pn & 7;
        const int row0 = pm * BM + wr * 64 + fr, col0 = pn * BM + wc * 32 + 8 * fq;
        if (br) run<1>(acc, row0, col0); else run<0>(acc, row0, col0);
    }
};

struct EpiRes {
    static constexpr bool PERM = true, AFTER_DRAIN = false, ROWSCALE = false;
    const float* x32; float* out32; bf16_t* XB; float* SSQ;
    __device__ __forceinline__ void operator()(const f32x4 (&acc)[2][2][4][2], const Unit& u, int wr, int wc, int fr, int fq) const {
        const int row0 = u.pm * BM + wr * 64 + fr, col0 = u.pn * BM + wc * 32 + 8 * fq;
#pragma unroll
        for (int ai = 0; ai < 2; ++ai) {
            f32x4 xv[4][2][2];
            if (x32) {
#pragma unroll
                for (int m = 0; m < 4; ++m) { const size_t off = (size_t)(row0 + ai * HALF + m * 16) * 2048 + col0;
#pragma unroll
                    for (int bj = 0; bj < 2; ++bj)
#pragma unroll
                        for (int n = 0; n < 2; ++n) xv[m][bj][n] = *(const f32x4*)(x32 + off + bj * HALF + n * 4); }
                __builtin_amdgcn_sched_barrier(0);
            } else {
                u32x4 xb[4][2];
#pragma unroll
                for (int m = 0; m < 4; ++m) { const size_t off = (size_t)(row0 + ai * HALF + m * 16) * 2048 + col0;
#pragma unroll
                    for (int bj = 0; bj < 2; ++bj) xb[m][bj] = *(const u32x4*)(XB + off + bj * HALF); }
                __builtin_amdgcn_sched_barrier(0);
#pragma unroll
                for (int m = 0; m < 4; ++m)
#pragma unroll
                    for (int bj = 0; bj < 2; ++bj) { xv[m][bj][0] = bf_lo4(xb[m][bj]); xv[m][bj][1] = bf_hi4(xb[m][bj]); }
            }
#pragma unroll
            for (int m = 0; m < 4; ++m) { const int row = row0 + ai * HALF + m * 16; const size_t off = (size_t)row * 2048 + col0; float s = 0.f;
#pragma unroll
                for (int bj = 0; bj < 2; ++bj) { const f32x4 y0 = xv[m][bj][0] + acc[ai][bj][m][0], y1 = xv[m][bj][1] + acc[ai][bj][m][1];
                    if (out32) { *(f32x4*)(out32 + off + bj * HALF) = y0; *(f32x4*)(out32 + off + bj * HALF + 4) = y1; }
                    else { *(u32x4*)(XB + off + bj * HALF) = pack8(y0, y1);
                        s += ((y0[0] * y0[0] + y0[1] * y0[1]) + (y0[2] * y0[2] + y0[3] * y0[3])) + ((y1[0] * y1[0] + y1[1] * y1[1]) + (y1[2] * y1[2] + y1[3] * y1[3])); } }
                if (!out32) { auto r16 = __builtin_amdgcn_permlane16_swap(__float_as_uint(s), __float_as_uint(s), false, false); s = __uint_as_float(r16[0]) + __uint_as_float(r16[1]);
                    auto r32 = __builtin_amdgcn_permlane32_swap(__float_as_uint(s), __float_as_uint(s), false, false); s = __uint_as_float(r32[0]) + __uint_as_float(r32[1]);
                    if (fq == 0) SSQ[(size_t)row * 32 + u.pn * 4 + wc] = s; } }
            __builtin_amdgcn_sched_barrier(0);
        }
    }
};

__device__ __forceinline__ float dpp_ror1(float v) { return __uint_as_float(__builtin_amdgcn_update_dpp(0u, __float_as_uint(v), 0x121, 0xf, 0xf, true)); }
__device__ __forceinline__ float dpp_ror2(float v) { return __uint_as_float(__builtin_amdgcn_update_dpp(0u, __float_as_uint(v), 0x122, 0xf, 0xf, true)); }
struct EpiUC {
    static constexpr bool PERM = true, AFTER_DRAIN = false, ROWSCALE = true;
    PG8_LAS const float* rs; bf16_t* ACT; const float* cw; const float* cb; PG8_LAS float* xch;
    __device__ __forceinline__ void operator()(const f32x4 (&acc)[2][2][4][2], const Unit& u, int wr, int wc, int fr, int fq) const {
        const int R0 = 254 * u.pm - 2, ch = 128 * u.pn + 32 * wc + 8 * fq;
#pragma unroll
        for (int ai = 0; ai < 2; ++ai)
            if (fr >= 14) { PG8_LAS f32x4* d = (PG8_LAS f32x4*)(xch + ((((ai * 2 + wr) * 4 + wc) * 4 + fq) * 2 + (fr - 14)) * 16);
                d[0] = acc[ai][0][3][0]; d[1] = acc[ai][0][3][1]; d[2] = acc[ai][1][3][0]; d[3] = acc[ai][1][3][1]; }
        { const int e2 = 2 * (((wr * 4 + wc) * 4 + fq) * 16 + fr), kind = e2 >> 8, ci = ((e2 >> 7) & 1) * 5632 + 128 * u.pn + (e2 & 127);
          *(PG8_LAS f32x2*)(xch + 2048 + e2) = *(GAS const f32x2*)(kind < 3 ? cw + kind * 11264 + ci : cb + ci); }
        asm volatile("s_waitcnt lgkmcnt(0)" ::: "memory"); __builtin_amdgcn_s_barrier(); asm volatile("" ::: "memory");
        PG8_LAS const float* cl = xch + 2048 + 32 * wc + 8 * fq;
#pragma unroll
        for (int ai = 0; ai < 2; ++ai) {
            PG8_LAS const float* hb; { const int sai = wr ? ai : ai - 1, swr = wr ? 0 : 1; hb = xch + ((((sai * 2 + swr) * 4 + wc) * 4 + fq) * 2 + (fr - 14)) * 16; asm volatile("" : "+v"(hb)); }
            const int s0 = (R0 + ai * HALF + wr * 64) & 2047; const bool tail = s0 >= 1984;
            u32x2 held[4];
#pragma unroll
            for (int n = 0; n < 2; ++n) {
                f32x4 gl[4];
#pragma unroll
                for (int bj = 0; bj < 2; ++bj) {
                    const int c = bj * 128 + 4 * n;
                    const f32x4 w0 = *(PG8_LAS const f32x4*)(cl + c), w1 = *(PG8_LAS const f32x4*)(cl + 256 + c), w2 = *(PG8_LAS const f32x4*)(cl + 512 + c), bs = *(PG8_LAS const f32x4*)(cl + 768 + c);
                    f32x4 q1, q2;
                    { f32x4 hv = (f32x4){0.f, 0.f, 0.f, 0.f};
                      if ((ai | wr) && s0 != 0 && fr >= 14) hv = *(const PG8_LAS f32x4*)(hb + (2 * bj + n) * 4);
                      q1 = w1 * hv; q2 = w0 * hv; }
#pragma unroll
                    for (int m = 0; m < 4; ++m) { const int rho = ai * HALF + wr * 64 + m * 16 + fr, grow = R0 + rho;
                        const f32x4 cur = acc[ai][bj][m][n]; f32x4 u1 = w1 * cur, u2 = w0 * cur, y = bs + w2 * cur;
                        if (tail) { const int s = grow & 2047;
#pragma unroll
                            for (int j = 0; j < 4; ++j) { u1[j] = s == 2047 ? 0.f : u1[j]; u2[j] = s >= 2046 ? 0.f : u2[j]; } }
                        float z1[4], z2[4], y0 = y[0], y1 = y[1], y2 = y[2], y3 = y[3];
#pragma unroll
                        for (int j = 0; j < 4; ++j) { z1[j] = fr == 15 ? q1[j] : u1[j]; z2[j] = fr >= 14 ? q2[j] : u2[j]; }
                        asm volatile("s_nop 1\n\t"
                                     "v_add_f32_dpp %0, %4, %0 row_ror:1 row_mask:0xf bank_mask:0xf\n\tv_add_f32_dpp %1, %5, %1 row_ror:1 row_mask:0xf bank_mask:0xf\n\t"
                                     "v_add_f32_dpp %2, %6, %2 row_ror:1 row_mask:0xf bank_mask:0xf\n\tv_add_f32_dpp %3, %7, %3 row_ror:1 row_mask:0xf bank_mask:0xf\n\t"
                                     "v_add_f32_dpp %0, %8, %0 row_ror:2 row_mask:0xf bank_mask:0xf\n\tv_add_f32_dpp %1, %9, %1 row_ror:2 row_mask:0xf bank_mask:0xf\n\t"
                                     "v_add_f32_dpp %2, %10, %2 row_ror:2 row_mask:0xf bank_mask:0xf\n\tv_add_f32_dpp %3, %11, %3 row_ror:2 row_mask:0xf bank_mask:0xf"
                                     : "+v"(y0), "+v"(y1), "+v"(y2), "+v"(y3) : "v"(z1[0]), "v"(z1[1]), "v"(z1[2]), "v"(z1[3]), "v"(z2[0]), "v"(z2[1]), "v"(z2[2]), "v"(z2[3]));
                        y = (f32x4){y0, y1, y2, y3};
                        q1 = u1; q2 = u2; __builtin_amdgcn_sched_barrier(0);
                        if (bj == 0) { const f32x2 g0 = gelu_pk((f32x2){y[0], y[1]}), g1 = gelu_pk((f32x2){y[2], y[3]}); gl[m] = (f32x4){g0.x, g0.y, g1.x, g1.y}; }
                        else { const u32x2 o = pack4(gl[m] * y);
                            if (n == 0) held[m] = o;
                            else if (rho >= 2 && grow < 8192) { u32x4 w; w.x = held[m].x; w.y = held[m].y; w.z = o.x; w.w = o.y; ST_BIG((u32x4*)(ACT + (size_t)grow * 5632 + ch), w); } }
                    }
                    __builtin_amdgcn_sched_barrier(0);
                }
            }
        }
    }
};

struct BranchOrder {
    StaticOrder so; int G, c;
    __device__ void init(int G_, int c_) { so.init(8192, 2048, 1, 0); G = G_; c = c_; }
    __device__ bool next(int i, Unit& u) const { const int t = (i >> 1) * G + c; if (t >= 256) return false; Unit v; so.next(t, v); const int br = i & 1; u.pm = v.pm + 32 * br; u.pn = v.pn + 8 * br; return true; }
    __device__ __forceinline__ void a_ready(const Unit&) const {}
    __device__ __forceinline__ void done(const Unit&) const {}
};
template <class Epi, class Sched, bool ALIGN_EPI = false, bool SP2 = false>
__device__ __forceinline__ void gemm_phase(PG8_LAS unsigned char* lds, const Gemm g, const Sched& S, const Epi& E) {
    int tid_o; asm volatile("v_mbcnt_lo_u32_b32 %0, -1, 0\n\tv_mbcnt_hi_u32_b32 %0, -1, %0" : "=v"(tid_o)); tid_o += g.wave_s * 64;
    const int tid = tid_o, wid = __builtin_amdgcn_readfirstlane(tid >> 6), lane = tid & 63, wr = wid >> 2, wc = wid & 3, fr = lane & 15, fq = lane >> 4;
    const int K = g.K, nt = K / BK;
    unsigned voffA[2], voffB[2];
#pragma unroll
    for (int i = 0; i < 2; ++i) { int R, C; stage_rc(tid * 16 + i * 8192, R, C); const int Rb = Epi::PERM ? ((R & ~31) + perm32(R & 31)) : R;
        voffA[i] = (unsigned)(R * K + C) * 2u; voffB[i] = (unsigned)(Rb * K + C) * 2u; }
    const size_t kstep = (size_t)(BK * 2);
    const size_t hstep = (size_t)HALF * K * 2;
    const size_t tstep = 2 * hstep;
    const size_t tstepA = g.a_rows ? (size_t)g.a_rows * K * 2 : tstep;
    const unsigned ldsw = (unsigned)wid * 1024u;
    const int aoff = lds_byte(wr * 64 + fr, fq * 8), boff = lds_byte(wc * 32 + fr, fq * 8);
#define PG8_SA(b, h) (((b) * 2 + (h)) * HTB)
#define PG8_SB(b, h) ((4 + (b) * 2 + (h)) * HTB)
#define PG8_STAGE(bufoff, gbase, voff) do { _Pragma("unroll") for (int _i = 0; _i < 2; ++_i) \
        __builtin_amdgcn_global_load_lds((const unsigned*)((const char*)(gbase) + (voff)[_i]), (PG8_LAS unsigned*)(lds + (bufoff) + ldsw + _i * 8192), 16, 0, 0); } while (0)
#define PG8_LDA(dst, b, h) do { _Pragma("unroll") for (int m = 0; m < 4; ++m) _Pragma("unroll") for (int k = 0; k < 2; ++k) dst[m][k] = *(const PG8_LAS bf16x8*)(lds + PG8_SA(b, h) + aoff + m * 2048 + k * 1024); } while (0)
#define PG8_LDB(dst, b, h) do { _Pragma("unroll") for (int n = 0; n < 2; ++n) _Pragma("unroll") for (int k = 0; k < 2; ++k) dst[n][k] = *(const PG8_LAS bf16x8*)(lds + PG8_SB(b, h) + boff + n * 2048 + k * 1024); } while (0)
#define PG8_MMA(ai, bj, At, Bt) do { __builtin_amdgcn_s_setprio(1); _Pragma("unroll") for (int m = 0; m < 4; ++m) _Pragma("unroll") for (int n = 0; n < 2; ++n) _Pragma("unroll") for (int k = 0; k < 2; ++k) \
        acc[ai][bj][m][n] = __builtin_amdgcn_mfma_f32_16x16x32_bf16(Bt[n][k], At[m][k], acc[ai][bj][m][n], 0, 0, 0); __builtin_amdgcn_s_setprio(0); } while (0)
#define PG8_WAIT_V(n) asm volatile("s_waitcnt vmcnt(" #n ")" ::: "memory")
#define PG8_WAIT_L(n) asm volatile("s_waitcnt lgkmcnt(" #n ")" ::: "memory")
#define PG8_BAR __builtin_amdgcn_s_barrier()
#define PG8_SCHED __builtin_amdgcn_sched_barrier(0)
    Unit cur, nxt; int ui = 0;
    if (!S.next(0, cur)) return;
    f32x4 acc[2][2][4][2];
#pragma unroll
    for (int a = 0; a < 2; ++a)
#pragma unroll
        for (int b = 0; b < 2; ++b)
#pragma unroll
            for (int m = 0; m < 4; ++m)
#pragma unroll
                for (int n = 0; n < 2; ++n) acc[a][b][m][n] = (f32x4){0.f, 0.f, 0.f, 0.f};
    bf16x8 At[4][2], B0[2][2], B1[2][2];
    const char* cA = (const char*)g.A + (size_t)cur.pm * tstepA; const char* cB = (const char*)g.Bt + (size_t)cur.pn * tstep;
    S.a_ready(cur);
    if constexpr (SP2) {
        PG8_STAGE(PG8_SB(0, 0), cB, voffB); PG8_STAGE(PG8_SB(0, 1), cB + hstep, voffB); PG8_STAGE(PG8_SA(0, 0), cA, voffA); PG8_STAGE(PG8_SA(0, 1), cA + hstep, voffA);
        if (wr == 1) PG8_BAR;
        PG8_WAIT_V(2); PG8_BAR;
        PG8_STAGE(PG8_SB(1, 0), cB + kstep, voffB); PG8_STAGE(PG8_SA(1, 0), cA + kstep, voffA); PG8_STAGE(PG8_SB(1, 1), cB + hstep + kstep, voffB);
        PG8_WAIT_V(6); PG8_BAR;
    } else {
        PG8_STAGE(PG8_SB(0, 0), cB, voffB); PG8_STAGE(PG8_SA(0, 0), cA, voffA); PG8_STAGE(PG8_SB(0, 1), cB + hstep, voffB); PG8_STAGE(PG8_SA(0, 1), cA + hstep, voffA);
        if (wr == 1) PG8_BAR;
        PG8_WAIT_V(4); PG8_BAR;
        PG8_STAGE(PG8_SB(1, 0), cB + kstep, voffB); PG8_STAGE(PG8_SA(1, 0), cA + kstep, voffA); PG8_STAGE(PG8_SB(1, 1), cB + hstep + kstep, voffB);
        PG8_WAIT_V(6); PG8_BAR;
    }
    for (;;) {
        const bool has_next = S.next(ui + 1, nxt);
        const char* nA = has_next ? (const char*)g.A + (size_t)nxt.pm * tstepA : cA; const char* nB = has_next ? (const char*)g.Bt + (size_t)nxt.pn * tstep : cB;
        for (int t = 0; t < nt; t += 2) {
            const bool last = (t == nt - 2);
            const char* a1 = cA + (size_t)(t + 1) * kstep;
            const char* a2 = last ? nA : cA + (size_t)(t + 2) * kstep; const char* b2 = last ? nB : cB + (size_t)(t + 2) * kstep;
            const char* a3 = a2 + kstep; const char* b3 = b2 + kstep;
            if (last && has_next) S.a_ready(nxt);
            if constexpr (SP2) {
            PG8_LDB(B0, 0, 0); PG8_LDB(B1, 0, 1); PG8_SCHED; PG8_LDA(At, 0, 0); PG8_STAGE(PG8_SA(1, 1), a1 + hstep, voffA);
            PG8_WAIT_V(8); PG8_WAIT_L(0); PG8_BAR; PG8_MMA(0, 0, At, B0); PG8_MMA(0, 1, At, B1); PG8_BAR; PG8_SCHED;
            PG8_LDA(At, 0, 1); PG8_STAGE(PG8_SB(0, 0), b2, voffB); PG8_STAGE(PG8_SB(0, 1), b2 + hstep, voffB); PG8_STAGE(PG8_SA(0, 0), a2, voffA);
            PG8_WAIT_V(8); PG8_WAIT_L(0); PG8_BAR; PG8_MMA(1, 0, At, B0); PG8_MMA(1, 1, At, B1); PG8_BAR; PG8_SCHED;
            PG8_LDB(B0, 1, 0); PG8_LDB(B1, 1, 1); PG8_SCHED; PG8_LDA(At, 1, 0); PG8_STAGE(PG8_SA(0, 1), a2 + hstep, voffA);
            PG8_WAIT_V(8); PG8_WAIT_L(0); PG8_BAR; PG8_MMA(0, 0, At, B0); PG8_MMA(0, 1, At, B1); PG8_BAR; PG8_SCHED;
            PG8_LDA(At, 1, 1); PG8_STAGE(PG8_SB(1, 0), b3, voffB); PG8_STAGE(PG8_SB(1, 1), b3 + hstep, voffB); PG8_STAGE(PG8_SA(1, 0), a3, voffA);
            PG8_WAIT_V(8); PG8_WAIT_L(0); PG8_BAR; PG8_MMA(1, 0, At, B0); PG8_MMA(1, 1, At, B1); PG8_BAR; PG8_SCHED;
            } else {
            PG8_LDB(B0, 0, 0); PG8_SCHED; PG8_LDA(At, 0, 0); PG8_STAGE(PG8_SA(1, 1), a1 + hstep, voffA);
            PG8_WAIT_L(8); PG8_BAR; PG8_WAIT_L(0); PG8_MMA(0, 0, At, B0); PG8_BAR; PG8_SCHED;
            PG8_LDB(B1, 0, 1); PG8_STAGE(PG8_SB(0, 0), b2, voffB);
            PG8_BAR; PG8_WAIT_L(0); PG8_MMA(0, 1, At, B1); PG8_BAR;
            PG8_LDA(At, 0, 1); PG8_STAGE(PG8_SA(0, 0), a2, voffA);
            PG8_BAR; PG8_WAIT_L(0); PG8_MMA(1, 0, At, B0); PG8_BAR; PG8_SCHED;
            PG8_STAGE(PG8_SB(0, 1), b2 + hstep, voffB);
            PG8_WAIT_V(6); PG8_BAR; PG8_MMA(1, 1, At, B1); PG8_BAR;
            PG8_LDB(B0, 1, 0); PG8_SCHED; PG8_LDA(At, 1, 0); PG8_STAGE(PG8_SA(0, 1), a2 + hstep, voffA);
            PG8_WAIT_L(8); PG8_BAR; PG8_WAIT_L(0); PG8_MMA(0, 0, At, B0); PG8_BAR; PG8_SCHED;
            PG8_LDB(B1, 1, 1); PG8_STAGE(PG8_SB(1, 0), b3, voffB);
            PG8_BAR; PG8_WAIT_L(0); PG8_MMA(0, 1, At, B1); PG8_BAR;
            PG8_LDA(At, 1, 1); PG8_STAGE(PG8_SA(1, 0), a3, voffA);
            PG8_BAR; PG8_WAIT_L(0); PG8_MMA(1, 0, At, B0); PG8_BAR; PG8_SCHED;
            PG8_STAGE(PG8_SB(1, 1), b3 + hstep, voffB);
            PG8_WAIT_V(6); PG8_BAR; PG8_MMA(1, 1, At, B1); PG8_BAR;
            }
        }
        if constexpr (ALIGN_EPI) { if (wr == 0) PG8_BAR; }
        if constexpr (Epi::ROWSCALE) {
            const PG8_LAS float* rp = E.rs + ui * 256 + wr * 64 + fr;
#pragma unroll
            for (int a = 0; a < 2; ++a)
#pragma unroll
                for (int m = 0; m < 4; ++m) { const float r = rp[a * HALF + m * 16];
#pragma unroll
                    for (int b = 0; b < 2; ++b)
#pragma unroll
                        for (int n = 0; n < 2; ++n) acc[a][b][m][n] *= r; }
        }
        if constexpr (!Epi::AFTER_DRAIN) { E(acc, cur, wr, wc, fr, fq); S.done(cur); }
        if (!has_next) break;
#pragma unroll
        for (int a = 0; a < 2; ++a)
#pragma unroll
            for (int b = 0; b < 2; ++b)
#pragma unroll
                for (int m = 0; m < 4; ++m)
#pragma unroll
                    for (int n = 0; n < 2; ++n) acc[a][b][m][n] = (f32x4){0.f, 0.f, 0.f, 0.f};
        cur = nxt; cA = nA; cB = nB; ++ui;
        if constexpr (ALIGN_EPI) { if (wr == 1) PG8_BAR; }
    }
    PG8_WAIT_V(0);
    if constexpr (!ALIGN_EPI) { if (wr == 0) PG8_BAR; }
    PG8_BAR;
    if constexpr (Epi::AFTER_DRAIN) { E.fused(acc, cur, wr, wc, fr, fq, lds, wid, lane); S.done(cur); }
#undef PG8_SA
#undef PG8_SB
#undef PG8_STAGE
#undef PG8_LDA
#undef PG8_LDB
#undef PG8_MMA
#undef PG8_WAIT_V
#undef PG8_WAIT_L
#undef PG8_BAR
#undef PG8_SCHED
}
}

constexpr int D_MODEL = 2048, BATCH = 4, SEQ = 2048, DEPTH = 4, M = BATCH * SEQ;
constexpr size_t ZS = (size_t)M * 1024;
constexpr int CHUNK = 64, NPREV = 8, NBAND = 9, HEADS = 8, HD = 128, AW = 1024, RELCLIP = 256, NREL = 2 * RELCLIP + 1;
constexpr int D_FF = 5632, D_IN = 11264;
constexpr int ZP = 1024;
constexpr float EPS = 1e-6f;
typedef unsigned short bf16;
typedef float f32x4 __attribute__((ext_vector_type(4)));
typedef unsigned v4u __attribute__((ext_vector_type(4)));
typedef unsigned v2u __attribute__((ext_vector_type(2)));
#define LAS __attribute__((address_space(3)))
#define GAS __attribute__((address_space(1)))
typedef GAS unsigned gu32;
#define RLX_AGENT __ATOMIC_RELAXED, __HIP_MEMORY_SCOPE_AGENT
#define LDS_WAIT() asm volatile("s_waitcnt lgkmcnt(0)" ::: "memory")
#define VM_WAIT() asm volatile("s_waitcnt vmcnt(0)" ::: "memory")
constexpr int NWAVES = 8;

__device__ __forceinline__ unsigned f2bf(float f) { unsigned u = __builtin_bit_cast(unsigned, f); return (u + 0x7fffu + ((u >> 16) & 1u)) >> 16; }
__device__ __forceinline__ unsigned pk2(float lo, float hi) { return f2bf(lo) | (f2bf(hi) << 16); }
__device__ __forceinline__ float bf2f(bf16 b) { return __uint_as_float(((unsigned)b) << 16); }
__device__ __forceinline__ float lg2_gamma(int h) { const float e = __builtin_ldexpf(1.0f, -5 - h);
    return -1.4426950408889634f * e * (1.0f + e * (0.5f + e * (0.3333333333f + e * (0.25f + e * (0.2f + e * 0.1666666667f))))); }
#define DPP_ROR(v, n) __uint_as_float(__builtin_amdgcn_update_dpp(0u, __float_as_uint(v), 0x120 + (n), 0xf, 0xf, true))
__device__ __forceinline__ float swap16_sum(float v) { auto rr = __builtin_amdgcn_permlane16_swap(__float_as_uint(v), __float_as_uint(v), false, false); return __uint_as_float(rr[0]) + __uint_as_float(rr[1]); }
__device__ __forceinline__ float swap32_sum(float v) { auto rr = __builtin_amdgcn_permlane32_swap(__float_as_uint(v), __float_as_uint(v), false, false); return __uint_as_float(rr[0]) + __uint_as_float(rr[1]); }
__device__ __forceinline__ float swap16_max(float v) { auto rr = __builtin_amdgcn_permlane16_swap(__float_as_uint(v), __float_as_uint(v), false, false); return fmaxf(__uint_as_float(rr[0]), __uint_as_float(rr[1])); }
__device__ __forceinline__ float swap32_max(float v) { auto rr = __builtin_amdgcn_permlane32_swap(__float_as_uint(v), __float_as_uint(v), false, false); return fmaxf(__uint_as_float(rr[0]), __uint_as_float(rr[1])); }
__device__ __forceinline__ float wave_sum(float v) {
    v += DPP_ROR(v, 8); v += DPP_ROR(v, 4); v += DPP_ROR(v, 2); v += DPP_ROR(v, 1);
    return swap32_sum(swap16_sum(v));
}
__device__ __forceinline__ float wave_max(float v) {
    v = fmaxf(v, DPP_ROR(v, 8)); v = fmaxf(v, DPP_ROR(v, 4)); v = fmaxf(v, DPP_ROR(v, 2)); v = fmaxf(v, DPP_ROR(v, 1));
    return swap32_max(swap16_max(v));
}

#define GIN(k) ((const float*)(GAS const float*)args.in[k])
__device__ __forceinline__ int tid_now(int wave_s) { int l; asm volatile("v_mbcnt_lo_u32_b32 %0, -1, 0\n\tv_mbcnt_hi_u32_b32 %0, -1, %0" : "=v"(l)); return wave_s * 64 + l; }
template <class T> __device__ __forceinline__ T* opq_global(T* p) { GAS T* g = (GAS T*)p; asm volatile("" : "+s"(g)); return (T*)g; }
constexpr int NPH = 6;
enum { PH_GEMM1 = 0, PH_MIX, PH_BR, PH_WO, PH_UP, PH_DOWN };
constexpr int N_PHASES = 1 + DEPTH * NPH;
#ifndef PROBE_PH
#define PROBE_PH (-1)
#endif
#ifndef PROBE_N
#define PROBE_N 2
#endif
#ifndef ONE_LAUNCH
#define ONE_LAUNCH 1
#endif

constexpr size_t MiB = 1u << 20;
constexpr size_t WS_CTL = 0, CTL_ZERO_BYTES = 1 * MiB;
constexpr size_t WS_WIN = 1 * MiB, WS_WBR = WS_WIN + 176 * MiB, WS_WO = WS_WBR + 32 * MiB, WS_WUP = WS_WO + 32 * MiB, WS_WDN = WS_WUP + 176 * MiB;
constexpr size_t WS_CS = WS_WDN + 88 * MiB;
constexpr size_t WS_X = WS_CS + 1 * MiB, WS_H0 = WS_X + 64 * MiB, WS_H = WS_H0 + 1 * MiB, WS_ZB = WS_H0 + 34 * MiB;
constexpr size_t WS_KV = WS_ZB + 176 * MiB, WS_RP = WS_KV + 64 * MiB, WS_SSQ = WS_KV + 32 * MiB;
constexpr size_t WS_YAR = WS_RP + 32 * MiB, WS_MRG = WS_YAR + 32 * MiB, WS_ACT = WS_MRG + 32 * MiB, WS_END = WS_ACT + 88 * MiB;
constexpr int CW_TMO = 64, CW_FLAG = 16384;
constexpr int CW_CQ = 8192;
constexpr int CW_BAR = 4096;

constexpr int RING_OFF = 0, RING_BYTES = 131072, XCH_OFF = RING_BYTES, XCH_BYTES = 8192;
constexpr int LDS_BYTES = 163840, MISC_OFF = LDS_BYTES - 256, RS_OFF = XCH_OFF + 12288;

struct Args { const float* in[14]; float* out; unsigned char* ws; int ph_lo, ph_hi; };

#ifndef PROBE_WRITES
#define PROBE_WRITES 0
#endif
struct ConvItem { const float* W; bf16* WT; const float* g; int K, N, r, mode; };
constexpr int I_IN = (D_MODEL / 64) * (D_IN / 64), I_BR = 2 * (AW / 64) * (D_MODEL / 64), I_O = (D_MODEL / 64) * (D_MODEL / 64), I_UP = I_IN, I_DN = (D_FF / 64) * (D_MODEL / 64);
constexpr int I_L = I_IN + I_BR + I_O + I_UP + I_DN;
#ifndef TAIL_PCT
#define TAIL_PCT 100
#endif
#ifndef TAIL1_PCT
#define TAIL1_PCT 60
#endif
constexpr int I_PRO = I_L - (I_L / 100) * TAIL_PCT, I_SPLIT = I_PRO + ((I_L - I_PRO) / 100) * TAIL1_PCT;
__device__ __forceinline__ ConvItem conv_item(const Args& args, unsigned char* ws, int git) {
    const int l = git / I_L; int r = git % I_L; ConvItem c; c.K = D_MODEL; c.N = D_IN; c.mode = 0; c.g = nullptr;
    if (r < I_IN) { c.W = GIN(1) + (size_t)l * D_MODEL * D_IN; c.WT = (bf16*)(ws + WS_WIN) + (size_t)l * D_IN * D_MODEL; c.mode = 1; c.g = GIN(4) + (size_t)l * D_MODEL; }
    else if ((r -= I_IN) < I_BR) { const int br = r / (I_BR / 2); r -= br * (I_BR / 2); c.K = AW; c.N = D_MODEL; c.W = GIN(2) + (size_t)(2 * l + br) * AW * D_MODEL; c.WT = (bf16*)(ws + WS_WBR) + (size_t)(2 * l + br) * D_MODEL * AW; }
    else if ((r -= I_BR) < I_O) { c.N = D_MODEL; c.W = GIN(3) + (size_t)l * D_MODEL * D_MODEL; c.WT = (bf16*)(ws + WS_WO) + (size_t)l * D_MODEL * D_MODEL; }
    else if ((r -= I_O) < I_UP) { c.W = GIN(10) + (size_t)l * D_MODEL * D_IN; c.WT = (bf16*)(ws + WS_WUP) + (size_t)l * D_IN * D_MODEL; c.mode = 2; c.g = GIN(9) + (size_t)l * D_MODEL; }
    else { r -= I_UP; c.K = D_FF; c.N = D_MODEL; c.W = GIN(13) + (size_t)l * D_FF * D_MODEL; c.WT = (bf16*)(ws + WS_WDN) + (size_t)l * D_MODEL * D_FF; }
    c.r = r; return c;
}
__device__ __forceinline__ void conv_load(const ConvItem& c, const float* gdef, f32x4 (&v)[16], f32x4 (&gk)[2], int lane) {
    const int nblk = c.N / 64, k0 = 64 * (c.r / nblk), n0 = 64 * (c.r % nblk); const float* p = c.W + (size_t)(k0 + (lane >> 4)) * c.N + n0 + 4 * (lane & 15);
#pragma unroll
    for (int j = 0; j < 16; ++j) v[j] = __builtin_nontemporal_load((const f32x4*)(p + (size_t)(4 * j) * c.N));
    const float* gp = (c.g ? c.g : gdef) + (c.g ? k0 : 0) + 8 * (lane & 7);
    gk[0] = *(const f32x4*)gp; gk[1] = *(const f32x4*)(gp + 4);
}
__device__ __forceinline__ void conv_store(const ConvItem& cc, const f32x4 (&v)[16], const f32x4 (&gk)[2], LAS float* scr, int lane) {
    const int nblk = cc.N / 64, k0 = 64 * (cc.r / nblk), n0 = 64 * (cc.r % nblk), K = cc.K, mode = cc.mode;
    { LAS float* d = scr + (lane >> 4) * 65 + 4 * (lane & 15);
#pragma unroll
      for (int j = 0; j < 16; ++j) { d[4 * j * 65] = v[j].x; d[4 * j * 65 + 1] = v[j].y; d[4 * j * 65 + 2] = v[j].z; d[4 * j * 65 + 3] = v[j].w; } }
    LDS_WAIT(); asm volatile("" ::: "memory");
    const int c = lane & 7; const bool has = cc.g != nullptr; const f32x4 one4 = (f32x4){1.f, 1.f, 1.f, 1.f}; const f32x4 g0 = has ? gk[0] : one4, g1 = has ? gk[1] : one4;
#pragma unroll
    for (int j = 0; j < 8; ++j) { const int n = (lane >> 3) + 8 * j; const LAS float* s = scr + (8 * c) * 65 + n;
        v4u o; o.x = pk2(s[0 * 65] * g0.x, s[1 * 65] * g0.y); o.y = pk2(s[2 * 65] * g0.z, s[3 * 65] * g0.w); o.z = pk2(s[4 * 65] * g1.x, s[5 * 65] * g1.y); o.w = pk2(s[6 * 65] * g1.z, s[7 * 65] * g1.w);
        const int col = n0 + n; int drow = col;
        if (mode == 2) { const int half = col >= D_FF, ch = half ? col - D_FF : col; drow = 256 * (ch >> 7) + 128 * half + (ch & 127); }
        if (mode == 1) { const int sec = col >> 10; if (sec == 3 || sec == 4) { const int hd = (col >> 7) & 1, d = col & 127; drow = (col & ~255) + 128 * (d >> 6) + 64 * hd + (d & 63); } }
        *(v4u*)(cc.WT + (size_t)drow * K + k0 + 8 * c) = o; }
    LDS_WAIT(); asm volatile("" ::: "memory");
}
__device__ __forceinline__ void convert_all(const Args& args, unsigned char* ws, int first, int nitems, int wi, int nw, LAS float* scr, int lane) {
    f32x4 va[16], vb[16], ga[2], gb[2]; int it = first + wi;
    if (it >= nitems) return;
    const float* gdef = GIN(4); const int last = it + ((nitems - 1 - it) / nw) * nw;
    ConvItem ca = conv_item(args, ws, it), cb; conv_load(ca, gdef, va, ga, lane);
    for (;;) {
        { const int nx = it + nw; cb = conv_item(args, ws, nx <= last ? nx : last); conv_load(cb, gdef, vb, gb, lane); }
        conv_store(ca, va, ga, scr, lane); if (it + nw > last) break; it += nw;
        { const int nx = it + nw; ca = conv_item(args, ws, nx <= last ? nx : last); conv_load(ca, gdef, va, ga, lane); }
        conv_store(cb, vb, gb, scr, lane); if (it + nw > last) break; it += nw;
    }
}
#ifndef REP_G1
#define REP_G1 1
#endif
#ifndef REP_UP
#define REP_UP 1
#endif
#ifndef SPLIT_G1
#define SPLIT_G1 73
#endif
#ifndef SPLIT_UP
#define SPLIT_UP 70
#endif
#ifndef CONV_QUEUE
#define CONV_QUEUE 0
#endif
#ifndef CONV_FIRST
#define CONV_FIRST 1
#endif
#ifndef CONV_IN_TAILS
#define CONV_IN_TAILS 1
#endif
typedef short bf16x8 __attribute__((ext_vector_type(8)));
typedef short s16x4 __attribute__((ext_vector_type(4)));
typedef float f32x16 __attribute__((ext_vector_type(16)));
__device__ __forceinline__ int crow(int r, int hh) { return (r & 3) + 8 * (r >> 2) + 4 * hh; }
__device__ __forceinline__ s16x4 tr_read(LAS const unsigned char* p) { return __builtin_bit_cast(s16x4, __builtin_amdgcn_ds_read_tr16_b64_v4i16((LAS s16x4*)p)); }
__device__ __forceinline__ bf16x8 cat8(s16x4 a, s16x4 b) { return (bf16x8){a[0], a[1], a[2], a[3], b[0], b[1], b[2], b[3]}; }
__device__ __forceinline__ float swap_max(float v) { auto rr = __builtin_amdgcn_permlane32_swap(__float_as_uint(v), __float_as_uint(v), false, false); return fmaxf(__uint_as_float(rr[0]), __uint_as_float(rr[1])); }
__device__ __forceinline__ float swap_sum(float v) { auto rr = __builtin_amdgcn_permlane32_swap(__float_as_uint(v), __float_as_uint(v), false, false); return __uint_as_float(rr[0]) + __uint_as_float(rr[1]); }
__device__ __forceinline__ bf16x8 pack_frag(const f32x16& p, int s) {
    pg8::u32x4 w; w.x = pg8::cvt_pk_bf16(p[8 * s + 0], p[8 * s + 1]); w.y = pg8::cvt_pk_bf16(p[8 * s + 2], p[8 * s + 3]); w.z = pg8::cvt_pk_bf16(p[8 * s + 4], p[8 * s + 5]); w.w = pg8::cvt_pk_bf16(p[8 * s + 6], p[8 * s + 7]);
    return __builtin_bit_cast(bf16x8, w);
}
template <class T> __device__ __forceinline__ T gld(const void* base, unsigned off, int imm = 0) { return *(const T*)((const char*)base + (size_t)off + imm); }
template <class T> __device__ __forceinline__ void gst(void* base, unsigned off, int imm, T v) { *(T*)((char*)base + (size_t)off + imm) = v; }
struct MixAddr { unsigned dk, dv; };
__device__ __forceinline__ void mix_addr(MixAddr& A, int lane) {
    A.dk = (unsigned)(lane & 31) * (ZP * 2) + 16u * (unsigned)(lane >> 5);
    const int l5 = lane & 31; A.dv = (unsigned)(4 * (l5 >> 4) + ((lane & 7) >> 1)) * (ZP * 2) + 64u * (unsigned)(lane >> 5) + 32u * (unsigned)((l5 >> 3) & 1) + 16u * (unsigned)(lane & 1);
}
__device__ __forceinline__ void dma_k(const bf16* g, LAS unsigned char* img, const MixAddr& A, int wave) {
#pragma unroll
    for (int w = 0; w < 2; ++w) { const int P = 2 * wave + w; __builtin_amdgcn_global_load_lds((const unsigned*)((const char*)g + (size_t)(32 * (P >> 3)) * (ZP * 2) + 32 * (P & 7) + A.dk), (LAS unsigned*)(img + P * 1024), 16, 0, 0); }
}
__device__ __forceinline__ void dma_v(const bf16* g, LAS unsigned char* img, const MixAddr& A, int wave) {
#pragma unroll
    for (int w = 0; w < 2; ++w) { const int P = 2 * wave + w; __builtin_amdgcn_global_load_lds((const unsigned*)((const char*)g + (size_t)(8 * (P >> 1)) * (ZP * 2) + 128 * (P & 1) + A.dv), (LAS unsigned*)(img + P * 1024), 16, 0, 0); }
}
__device__ __forceinline__ bf16x8 kfrag(LAS const unsigned char* img, int lane, int kb, int ks) { return *(LAS const bf16x8*)(img + (8 * kb + ks) * 1024 + 16 * lane); }
__device__ __forceinline__ bf16x8 vfrag(LAS const unsigned char* img, int lane, int rb, int db) { return cat8(tr_read(img + ((rb >> 3) * 4 + db) * 512 + 8 * lane), tr_read(img + ((rb >> 3) * 4 + 4 + db) * 512 + 8 * lane)); }
#define MIX_WAIT_BAR(N) asm volatile("s_waitcnt vmcnt(" #N ")\n\ts_barrier" ::: "memory")

__device__ __forceinline__ void state_phase(LAS unsigned char* lds, unsigned char* ws, unsigned epoch, int bx, int G, int tid) {
    const int lane = tid & 63, wave = __builtin_amdgcn_readfirstlane(tid >> 6), hh = lane >> 5, l31 = lane & 31;
    constexpr int STG = 32768;
    const bf16* ZB = (const bf16*)(ws + WS_ZB);
    MixAddr A; mix_addr(A, lane);
    for (int u = bx; u < BATCH * HEADS * 8; u += G) {
        const int gq = (u & 7) * 4 + (u >> 6), qb = (u >> 3) & 7, h = gq & 7, b = gq >> 3;
        const bf16* kvbase = ZB + (size_t)b * SEQ * ZP + h * HD;
        {
            unsigned char* wsl = opq_global(ws);
            float* GS = (float*)(wsl + WS_KV); gu32* flags = (gu32*)(wsl + WS_CTL) + CW_FLAG; gu32* tmo = (gu32*)(wsl + WS_CTL) + CW_TMO; bf16* RP = (bf16*)(wsl + WS_RP);
            const float lg = lg2_gamma(h); const float g1 = __builtin_amdgcn_exp2f(lg), g63 = __builtin_amdgcn_exp2f(63.0f * lg), g64 = __builtin_amdgcn_exp2f(64.0f * lg), g256 = __builtin_amdgcn_exp2f(256.0f * lg);
#pragma unroll
            for (int ci = 0; ci < 4; ++ci) { const bf16* tp = kvbase + (size_t)((4 * qb + ci) * CHUNK) * ZP; dma_v(tp + 4 * ZS, lds + ci * STG, A, wave); dma_v(tp + 5 * ZS, lds + ci * STG + 16384, A, wave); }
            MIX_WAIT_BAR(0);
            f32x16 L[2]; unsigned Lp[3][2][8];
#pragma unroll
            for (int q = 0; q < 2; ++q)
#pragma unroll
                for (int r = 0; r < 16; ++r) L[q][r] = 0.f;
#pragma unroll
            for (int ci = 0; ci < 4; ++ci) { LAS const unsigned char* KI = lds + ci * STG; LAS const unsigned char* VI = KI + 16384;
#pragma unroll
                for (int q = 0; q < 2; ++q) { const int id = 2 * wave + q, eb = id >> 2, db = id & 3; f32x16 kv;
#pragma unroll
                    for (int r = 0; r < 16; ++r) kv[r] = 0.f;
                    bf16x8 af[4], bfr[4];
#pragma unroll
                    for (int ks = 0; ks < 4; ++ks) { af[ks] = vfrag(VI, lane, 16 * ks, eb); bfr[ks] = vfrag(KI, lane, 16 * ks, db); }
                    __builtin_amdgcn_sched_barrier(0);
#pragma unroll
                    for (int ks = 0; ks < 4; ++ks) kv = __builtin_amdgcn_mfma_f32_32x32x16_bf16(af[ks], bfr[ks], kv, 0, 0, 0);
#pragma unroll
                    for (int r = 0; r < 16; ++r) L[q][r] = L[q][r] * g64 + kv[r] * g63; }
                if (ci < 3) {
#pragma unroll
                    for (int q = 0; q < 2; ++q)
#pragma unroll
                        for (int r = 0; r < 8; ++r) Lp[ci][q][r] = pg8::cvt_pk_bf16(L[q][2 * r], L[q][2 * r + 1]); } }
            const unsigned go = (unsigned)(4 * hh * HD + l31) * 4u;
#pragma unroll
            for (int q = 0; q < 2; ++q) { const int id = 2 * wave + q, eb = id >> 2, db = id & 3; float* gs = GS + (size_t)u * (HD * HD) + 32 * eb * HD + 32 * db;
#pragma unroll
                for (int r = 0; r < 16; ++r) __hip_atomic_store((gu32*)((char*)(gs + 8 * (r >> 2) * HD) + (size_t)go + (r & 3) * HD * 4), __float_as_uint(L[q][r]), RLX_AGENT); }
            asm volatile("s_waitcnt vmcnt(0)" ::: "memory"); __syncthreads();
            if (tid == 0) __hip_atomic_store(flags + 64 * u, epoch, RLX_AGENT);
            if (tid < qb) { gu32* f = flags + 64 * (u - 8 * (qb - tid)); unsigned sp = 0;
                while (__hip_atomic_load(f, RLX_AGENT) != epoch) { __builtin_amdgcn_s_sleep(1);
                    if ((++sp & 255u) == 0u) { if (__hip_atomic_load(tmo, RLX_AGENT)) break; if (sp > (1u << 18)) { __hip_atomic_store(tmo, 1u, RLX_AGENT); break; } } } }
            __builtin_amdgcn_fence(__ATOMIC_ACQUIRE, "agent"); asm volatile("s_waitcnt vmcnt(0)" ::: "memory"); __syncthreads();
            f32x16 S[2];
#pragma unroll
            for (int q = 0; q < 2; ++q)
#pragma unroll
                for (int r = 0; r < 16; ++r) S[q][r] = 0.f;
            { float wgt = 1.0f;
#pragma unroll 1
              for (int gp = qb - 1; gp >= 0; gp -= 2) { const bool two = gp >= 1; const int gp2 = two ? gp - 1 : gp; float t0[2][16], t1[2][16];
#pragma unroll
                  for (int q = 0; q < 2; ++q) { const int id = 2 * wave + q, eb = id >> 2, db = id & 3;
                      const float* gg = GS + (size_t)(u - 8 * (qb - gp)) * (HD * HD) + 32 * eb * HD + 32 * db; const float* gh = GS + (size_t)(u - 8 * (qb - gp2)) * (HD * HD) + 32 * eb * HD + 32 * db;
#pragma unroll
                      for (int r = 0; r < 16; ++r) { t0[q][r] = gld<float>(gg + 8 * (r >> 2) * HD, go, (r & 3) * HD * 4); t1[q][r] = gld<float>(gh + 8 * (r >> 2) * HD, go, (r & 3) * HD * 4); } }
                  __builtin_amdgcn_sched_barrier(0);
                  const float w1 = two ? wgt * g256 : 0.f;
#pragma unroll
                  for (int q = 0; q < 2; ++q)
#pragma unroll
                      for (int r = 0; r < 16; ++r) S[q][r] += wgt * t0[q][r] + w1 * t1[q][r];
                  wgt *= g256 * g256; } }
            bf16* rpo = RP + ((size_t)((b * HEADS + h) * 32 + 4 * qb)) * (HD * HD);
#pragma unroll
            for (int half = 0; half < 2; ++half) {
#pragma unroll
                for (int j = 0; j < 2; ++j) { const int i = 2 * half + j;
#pragma unroll
                    for (int q = 0; q < 2; ++q) { const int id = 2 * wave + q, eb = id >> 2, db = id & 3; LAS float* img = (LAS float*)(lds + j * 65536);
#pragma unroll
                        for (int r = 0; r < 16; ++r) { const float li = i == 0 ? 0.f : ((r & 1) ? __uint_as_float(Lp[i ? i - 1 : 0][q][r >> 1] & 0xffff0000u) : __uint_as_float(Lp[i ? i - 1 : 0][q][r >> 1] << 16)); const float sc = i == 0 ? 1.0f : (i == 1 ? g64 : (i == 2 ? g64 * g64 : g64 * g64 * g64));
                            img[(32 * eb + crow(r, hh)) * HD + 32 * db + l31] = g1 * (sc * S[q][r] + li); } } }
                asm volatile("s_waitcnt lgkmcnt(0)\n\ts_barrier" ::: "memory");
#pragma unroll
                for (int k = 0; k < 8; ++k) {
                    const f32x4 a = *(LAS const f32x4*)(lds + tid * 32 + k * 16384), c = *(LAS const f32x4*)(lds + tid * 32 + k * 16384 + 16);
                    gst<pg8::u32x4>(rpo + (size_t)half * 2 * (HD * HD) + k * 4096, (unsigned)tid * 16u, 0, pg8::pack8(a, c)); }
                asm volatile("s_waitcnt lgkmcnt(0)\n\ts_barrier" ::: "memory");
            }
            asm volatile("s_waitcnt vmcnt(0)" ::: "memory"); __syncthreads();
        }
        __syncthreads();
    }
}
__device__ __forceinline__ void mix_phase(LAS unsigned char* lds, unsigned char* ws, unsigned epoch, const float* rel_bias, const float* rgain, int bx, int G, int tid) {
    const bf16* ZB = (const bf16*)(ws + WS_ZB);
    const int lane = tid & 63, wave = __builtin_amdgcn_readfirstlane(tid >> 6), hh = lane >> 5, l31 = lane & 31;
    constexpr int STG = 32768, BIAS_OFF = 4 * STG;
    LAS float* bias_s = (LAS float*)(lds + BIAS_OFF);
    MixAddr A; mix_addr(A, lane);
    for (int u = bx; u < BATCH * HEADS * 8; u += G) {
        const int gq = (u & 7) * 4 + (u >> 6), qb = (u >> 3) & 7, h = gq & 7, b = gq >> 3;
        const int cq = 4 * qb + (wave >> 1), nloc = 32 * (wave & 1) + l31;
        const bf16* zq = ZB + ((size_t)b * SEQ + cq * CHUNK) * ZP + h * HD;
        const unsigned zo = (unsigned)nloc * (ZP * 2) + 16 * hh;
        const bf16* kvbase = ZB + (size_t)b * SEQ * ZP + h * HD;
        bf16x8 qf[8]; f32x16 O[4];
        {
        for (int i = tid; i < NREL; i += 512) bias_s[i] = rel_bias[h * NREL + i] * 1.4426950408889634f;
#pragma unroll
        for (int ks = 0; ks < 8; ++ks) qf[ks] = gld<bf16x8>(zq, zo, 32 * ks);
#pragma unroll
        for (int db = 0; db < 4; ++db)
#pragma unroll
            for (int r = 0; r < 16; ++r) O[db][r] = 0.f;
        float m_run = -INFINITY, l_run = 0.f;
        const int t0 = (8 - 4 * qb) > 0 ? (8 - 4 * qb) : 0;
#pragma unroll
        for (int d = 0; d < 2; ++d) if (t0 + d < 12) { const bf16* tp = kvbase + (size_t)((4 * qb - 8 + t0 + d) * CHUNK) * ZP; dma_k(tp + ZS, lds + d * STG, A, wave); dma_v(tp + 2 * ZS, lds + d * STG + 16384, A, wave); }
#define PEND_PV() do { LAS const unsigned char* VP = lds + pend_st * STG + 16384; bf16x8 va_[8], vb_[8]; \
            _Pragma("unroll") for (int i = 0; i < 8; ++i) { va_[i] = vfrag(VP, lane, 16 * (i >> 2), i & 3); vb_[i] = vfrag(VP, lane, 32 + 16 * (i >> 2), i & 3); } \
            __builtin_amdgcn_sched_barrier(0); \
            _Pragma("unroll") for (int g = 0; g < 2; ++g) _Pragma("unroll") for (int db = 0; db < 4; ++db) O[db] = __builtin_amdgcn_mfma_f32_32x32x16_bf16(va_[4 * g + db], pfp[g], O[db], 0, 0, 0); \
            _Pragma("unroll") for (int g = 0; g < 2; ++g) _Pragma("unroll") for (int db = 0; db < 4; ++db) O[db] = __builtin_amdgcn_mfma_f32_32x32x16_bf16(vb_[4 * g + db], pfp[2 + g], O[db], 0, 0, 0); \
            pend_st = -1; } while (0)
        auto band_loop = [&](auto skc) __attribute__((always_inline)) { constexpr bool skew = decltype(skc)::value;
        bf16x8 pfp[4]; int pend_st = -1;
#pragma unroll
        for (int i = 0; i < 4; ++i) pfp[i] = (bf16x8){0, 0, 0, 0, 0, 0, 0, 0};
        int st = 0;
        for (int t = t0; t < 12; ++t) {
            const int kc = 4 * qb - 8 + t;
            if (t + 1 < 12) MIX_WAIT_BAR(4); else MIX_WAIT_BAR(0);
            if (t + 2 < 12) { const int s2 = (st + 2) & 3; const bf16* tp = kvbase + (size_t)((kc + 2) * CHUNK) * ZP;
                dma_k(tp + ZS, lds + s2 * STG, A, wave); dma_v(tp + 2 * ZS, lds + s2 * STG + 16384, A, wave); }
            if constexpr (skew) { if (pend_st >= 0) PEND_PV(); }
            if (kc >= cq - NPREV && kc <= cq) {
                LAS const unsigned char* KT = lds + st * STG; LAS const unsigned char* VT = KT + 16384;
                f32x16 s[2];
#pragma unroll
                for (int kb = 0; kb < 2; ++kb) { bf16x8 kf[8];
#pragma unroll
                    for (int i = 0; i < 8; ++i) kf[i] = kfrag(KT, lane, kb, i);
#pragma unroll
                    for (int r = 0; r < 16; ++r) s[kb][r] = 0.f;
                    __builtin_amdgcn_sched_barrier(0);
#pragma unroll
                    for (int ks = 0; ks < 8; ++ks) s[kb] = __builtin_amdgcn_mfma_f32_32x32x16_bf16(kf[ks], qf[ks], s[kb], 0, 0, 0);
                    __builtin_amdgcn_sched_barrier(0); }
                __builtin_amdgcn_sched_barrier(0);
                bf16x8 vfa[8];
                if constexpr (!skew) {
#pragma unroll
                    for (int i = 0; i < 8; ++i) vfa[i] = vfrag(VT, lane, 16 * (i >> 2), i & 3); }
                float mx = -INFINITY;
                if (cq - kc >= 5) { const float bc = bias_s[2 * RELCLIP];
#pragma unroll
                    for (int kb = 0; kb < 2; ++kb)
#pragma unroll
                        for (int r = 0; r < 16; ++r) { s[kb][r] += bc; mx = fmaxf(mx, s[kb][r]); }
                } else { const int dbase = (cq - kc) * CHUNK + nloc + RELCLIP - 4 * hh;
#pragma unroll
                    for (int kb = 0; kb < 2; ++kb) { float bv[16];
#pragma unroll
                        for (int r = 0; r < 16; ++r) { int idx = dbase - (32 * kb + (r & 3) + 8 * (r >> 2)); idx = idx > 2 * RELCLIP ? 2 * RELCLIP : idx; bv[r] = bias_s[idx]; }
                        __builtin_amdgcn_sched_barrier(0);
#pragma unroll
                        for (int r = 0; r < 16; ++r) { s[kb][r] += bv[r]; mx = fmaxf(mx, s[kb][r]); }
                        __builtin_amdgcn_sched_barrier(0); } }
                mx = swap_max(mx);
                const float m_new = fmaxf(m_run, mx), alpha = __builtin_amdgcn_exp2f(m_run - m_new); m_run = m_new;
                float ps = 0.f;
#pragma unroll
                for (int kb = 0; kb < 2; ++kb)
#pragma unroll
                    for (int r = 0; r < 16; ++r) { s[kb][r] = __builtin_amdgcn_exp2f(s[kb][r] - m_new); ps += s[kb][r]; }
                l_run = l_run * alpha + ps;
                if (__builtin_amdgcn_ballot_w64(alpha != 1.0f) != 0ull) {
#pragma unroll
                    for (int db = 0; db < 4; ++db)
#pragma unroll
                        for (int r = 0; r < 16; ++r) O[db][r] *= alpha; }
                __builtin_amdgcn_sched_barrier(0);
                if constexpr (!skew) {
                bf16x8 vfb[8];
#pragma unroll
                for (int i = 0; i < 8; ++i) vfb[i] = vfrag(VT, lane, 32 + 16 * (i >> 2), i & 3);
                __builtin_amdgcn_sched_barrier(0);
#pragma unroll
                for (int g = 0; g < 2; ++g) { const bf16x8 pf = pack_frag(s[0], g);
#pragma unroll
                    for (int db = 0; db < 4; ++db) O[db] = __builtin_amdgcn_mfma_f32_32x32x16_bf16(vfa[4 * g + db], pf, O[db], 0, 0, 0); }
#pragma unroll
                for (int g = 0; g < 2; ++g) { const bf16x8 pf = pack_frag(s[1], g);
#pragma unroll
                    for (int db = 0; db < 4; ++db) O[db] = __builtin_amdgcn_mfma_f32_32x32x16_bf16(vfb[4 * g + db], pf, O[db], 0, 0, 0); }
                } else { pfp[0] = pack_frag(s[0], 0); pfp[1] = pack_frag(s[0], 1); pfp[2] = pack_frag(s[1], 0); pfp[3] = pack_frag(s[1], 1); pend_st = st; }
            }
            st = (st + 1) & 3;
        }
        if constexpr (skew) { if (pend_st >= 0) PEND_PV(); }
        };
        if (wave >= 4) band_loop(std::integral_constant<bool, true>{}); else band_loop(std::integral_constant<bool, false>{});
#undef PEND_PV
        { unsigned char* wsl = opq_global(ws); bf16* YAR = (bf16*)(wsl + WS_YAR);
          const float rl = 1.0f / swap_sum(l_run); bf16* yq = YAR + ((size_t)b * SEQ + cq * CHUNK) * AW + h * HD; const unsigned yo = (unsigned)nloc * (AW * 2) + 8 * hh;
#pragma unroll
            for (int db = 0; db < 4; ++db)
#pragma unroll
                for (int rg = 0; rg < 4; ++rg) { v2u w; w.x = pg8::cvt_pk_bf16(O[db][4 * rg] * rl, O[db][4 * rg + 1] * rl); w.y = pg8::cvt_pk_bf16(O[db][4 * rg + 2] * rl, O[db][4 * rg + 3] * rl);
                    gst<v2u>(yq, yo, 64 * db + 16 * rg, w); } }
        asm volatile("s_waitcnt lgkmcnt(0)\n\ts_barrier" ::: "memory");
        }
        {
        const bf16* kvb = opq_global(kvbase);
#pragma unroll
        for (int ci = 0; ci < 4; ++ci) { const bf16* tp = kvb + (size_t)((4 * qb + ci) * CHUNK) * ZP; dma_k(tp + 4 * ZS, lds + ci * STG, A, wave); dma_v(tp + 5 * ZS, lds + ci * STG + 16384, A, wave); }
#pragma unroll
        for (int ks = 0; ks < 8; ++ks) qf[ks] = gld<bf16x8>(zq + 3 * ZS, zo, 32 * ks);
        unsigned char* wsb = opq_global(ws); const bf16* RP = (const bf16*)(wsb + WS_RP); bf16* YAR = (bf16*)(wsb + WS_YAR);
        const bf16* rq = RP + ((size_t)((b * HEADS + h) * 32 + cq)) * (HD * HD); const unsigned ro = (unsigned)l31 * (HD * 2) + 16 * hh;
        bf16x8 rf[16];
#pragma unroll
        for (int i = 0; i < 16; ++i) rf[i] = gld<bf16x8>(rq + 32 * (i >> 3) * HD, ro, 32 * (i & 7));
        __builtin_amdgcn_sched_barrier(0);
        MIX_WAIT_BAR(0);
        {
            LAS const unsigned char* KT = lds + (wave >> 1) * STG; LAS const unsigned char* VT = KT + 16384;
#pragma unroll
            for (int eb = 0; eb < 4; ++eb)
#pragma unroll
                for (int r = 0; r < 16; ++r) O[eb][r] = 0.f;
#pragma unroll
            for (int i = 0; i < 16; ++i) O[i >> 3] = __builtin_amdgcn_mfma_f32_32x32x16_bf16(rf[i], qf[i & 7], O[i >> 3], 0, 0, 0);
            __builtin_amdgcn_sched_barrier(0);
#pragma unroll
            for (int i = 0; i < 16; ++i) rf[i] = gld<bf16x8>(rq + 32 * (2 + (i >> 3)) * HD, ro, 32 * (i & 7));
            __builtin_amdgcn_sched_barrier(0);
#pragma unroll
            for (int mb = 0; mb < 2; ++mb) {
                if (mb <= (wave & 1)) {
                    f32x16 s;
#pragma unroll
                    for (int r = 0; r < 16; ++r) s[r] = 0.f;
                    { bf16x8 kf[8];
#pragma unroll
                      for (int ks = 0; ks < 8; ++ks) kf[ks] = kfrag(KT, lane, mb, ks);
                      __builtin_amdgcn_sched_barrier(0);
#pragma unroll
                      for (int ks = 0; ks < 8; ++ks) s = __builtin_amdgcn_mfma_f32_32x32x16_bf16(kf[ks], qf[ks], s, 0, 0, 0); }
#pragma unroll
                    for (int r = 0; r < 16; ++r) s[r] = (nloc >= 32 * mb + crow(r, hh)) ? s[r] : 0.f;
                    { bf16x8 vf[8];
#pragma unroll
                      for (int i = 0; i < 8; ++i) vf[i] = vfrag(VT, lane, 32 * mb + 16 * (i >> 2), i & 3);
                      __builtin_amdgcn_sched_barrier(0);
#pragma unroll
                      for (int sp = 0; sp < 2; ++sp) { const bf16x8 pf = pack_frag(s, sp);
#pragma unroll
                          for (int eb = 0; eb < 4; ++eb) O[eb] = __builtin_amdgcn_mfma_f32_32x32x16_bf16(vf[4 * sp + eb], pf, O[eb], 0, 0, 0); } }
                }
            }
#pragma unroll
            for (int i = 0; i < 16; ++i) O[2 + (i >> 3)] = __builtin_amdgcn_mfma_f32_32x32x16_bf16(rf[i], qf[i & 7], O[2 + (i >> 3)], 0, 0, 0);
            float ss = 0.f;
#pragma unroll
            for (int eb = 0; eb < 4; ++eb)
#pragma unroll
                for (int r = 0; r < 16; ++r) ss += O[eb][r] * O[eb][r];
            const float rstd = 1.0f / sqrtf(swap_sum(ss) * (1.0f / HD) + EPS);
            bf16* yq = YAR + (size_t)M * AW + ((size_t)b * SEQ + cq * CHUNK) * AW + h * HD; const unsigned yo = (unsigned)nloc * (AW * 2) + 8 * hh; const unsigned so = (unsigned)nloc * (ZP * 2) + 8 * hh;
#pragma unroll
            for (int e2 = 0; e2 < 2; ++e2) {
                f32x4 gn[2][4]; v2u sw[2][4];
#pragma unroll
                for (int ee = 0; ee < 2; ++ee)
#pragma unroll
                    for (int rg = 0; rg < 4; ++rg) { const int eb = 2 * e2 + ee; gn[ee][rg] = *(const f32x4*)(rgain + 32 * eb + 8 * rg + 4 * hh); sw[ee][rg] = gld<v2u>(zq + 6 * ZS, so, 64 * eb + 16 * rg); }
                __builtin_amdgcn_sched_barrier(0);
#pragma unroll
                for (int ee = 0; ee < 2; ++ee)
#pragma unroll
                    for (int rg = 0; rg < 4; ++rg) { const int eb = 2 * e2 + ee; const f32x4 g4 = gn[ee][rg]; const v2u s2 = sw[ee][rg];
                        const float s0 = __uint_as_float(s2.x << 16), s1 = __uint_as_float(s2.x & 0xffff0000u), s2f = __uint_as_float(s2.y << 16), s3 = __uint_as_float(s2.y & 0xffff0000u);
                        v2u w; w.x = pg8::cvt_pk_bf16(O[eb][4 * rg] * rstd * g4[0] * s0, O[eb][4 * rg + 1] * rstd * g4[1] * s1); w.y = pg8::cvt_pk_bf16(O[eb][4 * rg + 2] * rstd * g4[2] * s2f, O[eb][4 * rg + 3] * rstd * g4[3] * s3);
                        gst<v2u>(yq, yo, 64 * eb + 16 * rg, w); }
                __builtin_amdgcn_sched_barrier(0); }
        }
        __syncthreads();
        }
    }
}

__device__ __forceinline__ void cast_phase(const float* xs, bf16* XB, float* SSQ, int gw, int NGW, int lane) {
    for (int row = 2 * gw; row < M; row += 2 * NGW) {
        const f32x4* xr = (const f32x4*)(xs + (size_t)row * D_MODEL); f32x4 v[2][8]; float s0 = 0.f, s1 = 0.f;
#pragma unroll
        for (int j = 0; j < 8; ++j) { v[0][j] = xr[lane + 64 * j]; v[1][j] = xr[D_MODEL / 4 + lane + 64 * j]; }
        __builtin_amdgcn_sched_barrier(0);
#pragma unroll
        for (int j = 0; j < 8; ++j) { s0 += (v[0][j].x * v[0][j].x + v[0][j].y * v[0][j].y) + (v[0][j].z * v[0][j].z + v[0][j].w * v[0][j].w); s1 += (v[1][j].x * v[1][j].x + v[1][j].y * v[1][j].y) + (v[1][j].z * v[1][j].z + v[1][j].w * v[1][j].w); }
        const float t0 = wave_sum(s0), t1 = wave_sum(s1);
        v2u* o8 = (v2u*)(XB + (size_t)row * D_MODEL);
#pragma unroll
        for (int j = 0; j < 8; ++j) { v2u o; o.x = pk2(v[0][j].x, v[0][j].y); o.y = pk2(v[0][j].z, v[0][j].w); o8[lane + 64 * j] = o;
            o.x = pk2(v[1][j].x, v[1][j].y); o.y = pk2(v[1][j].z, v[1][j].w); o8[D_MODEL / 4 + lane + 64 * j] = o; }
        SSQ[(size_t)row * 32 + lane] = lane == 0 ? t0 : lane == 32 ? t1 : 0.f;
    }
}
__device__ __forceinline__ void deal_table(LAS unsigned char* lds, int Mrows, int Ncols, int G, int bx, int tid) {
    LAS int* tab = (LAS int*)(lds + MISC_OFF + 128);
    if (tid < 64) { pg8::XcdDeal D; D.init(Mrows, Ncols, G, bx);
#pragma unroll 1
        for (int i = 0; i < 8; ++i) { pg8::Unit u; u.pm = 0; u.pn = 0; const bool ok = D.next(i, u); if (tid == 0) { tab[2 * i] = ok ? u.pm : -1; tab[2 * i + 1] = ok ? u.pn : 0; } }
        if (tid == 0) { tab[16] = D.conv_rank; tab[17] = D.nconv; } }
    __syncthreads();
}
template <class Sched>
__device__ __forceinline__ void rs_prepare(const Sched& S, const float* SSQ, LAS float* rs, int a_rows, int tid) {
    const int t = tid >> 1, hf = tid & 1; f32x4 p[6][4];
#pragma unroll
    for (int ui = 0; ui < 6; ++ui) { pg8::Unit u; u.pm = 0; u.pn = 0; (void)S.next(ui, u);
        int row = (a_rows ? a_rows * u.pm - 2 : 256 * u.pm) + t; row = row < 0 ? 0 : row > M - 1 ? M - 1 : row;
        const f32x4* q = (const f32x4*)(SSQ + (size_t)row * 32 + hf * 16);
#pragma unroll
        for (int k = 0; k < 4; ++k) p[ui][k] = q[k]; }
    __builtin_amdgcn_sched_barrier(0);
#pragma unroll
    for (int ui = 0; ui < 6; ++ui) { const f32x4 a = (p[ui][0] + p[ui][1]) + (p[ui][2] + p[ui][3]); float s = (a.x + a.y) + (a.z + a.w);
        s += __uint_as_float(__builtin_amdgcn_update_dpp(0u, __float_as_uint(s), 0xB1, 0xf, 0xf, true));
        if (!hf) rs[ui * 256 + t] = 1.0f / sqrtf(s * (1.0f / D_MODEL) + EPS); }
    __syncthreads();
}
#define XB_TMO      128
#define XB_XCNT(j)  (256  + 64 * (j))
#define XB_XSUB(j)  (1280 + 64 * (j))
#define XB_XGEN(j)  (2304 + 64 * (j))
#define XB_TOP      3328
#define XB_TOPGEN   3392
#define XCD_BAR_WORDS 3456
#define XB_SPIN_CAP (1u << 18)

__device__ __forceinline__ unsigned xb_ld(unsigned* p)              { return __hip_atomic_load(p, __ATOMIC_RELAXED, __HIP_MEMORY_SCOPE_AGENT); }
__device__ __forceinline__ unsigned xb_add(unsigned* p, unsigned v) { return __hip_atomic_fetch_add(p, v, __ATOMIC_RELAXED, __HIP_MEMORY_SCOPE_AGENT); }
__device__ __forceinline__ unsigned xb_xcc_id() { return (unsigned)__builtin_amdgcn_s_getreg((3 << 11) | 20) & 0xFu; }
#define XB_SPIN(cond, bar) do { unsigned _sp = 0; while (cond) { __builtin_amdgcn_s_sleep(1); \
    if ((++_sp & 255u) == 0u) { if (xb_ld(&(bar)[XB_TMO])) break; if (_sp > XB_SPIN_CAP) { atomicAdd(&(bar)[XB_TMO], 1u); break; } } } } while (0)

struct XcdBarrier {
    unsigned* bar; unsigned x;
    volatile LAS unsigned* st;
    bool t0;
};

__device__ __forceinline__ XcdBarrier xcd_barrier_post(unsigned* bar, volatile LAS unsigned* st) {
    XcdBarrier b; b.bar = bar; b.x = xb_xcc_id(); b.st = st; b.t0 = threadIdx.x == 0;
    if (b.t0) (void)xb_add(&bar[XB_XCNT(b.x)], 1u);
    return b;
}
__device__ __forceinline__ void xcd_barrier_complete(unsigned* bar, unsigned x, unsigned& nloc, unsigned& nx) {
    const unsigned G = gridDim.x * gridDim.y * gridDim.z;
    unsigned sum, cnt, mine, sp = 0u;
    for (;;) {
        sum = 0u; cnt = 0u; mine = 0u;
#pragma unroll
        for (unsigned j = 0; j < 16; ++j) { const unsigned c = xb_ld(&bar[XB_XCNT(j)]); sum += c; cnt += (c > 0u) ? 1u : 0u; mine = (j == x) ? c : mine; }
        if (sum == G) break;
        __builtin_amdgcn_s_sleep(1);
        if ((++sp & 255u) == 0u) { if (xb_ld(&bar[XB_TMO])) break; if (sp > XB_SPIN_CAP) { atomicAdd(&bar[XB_TMO], 1u); break; } }
    }
    nloc = mine > 0u ? mine : 1u; nx = cnt > 0u ? cnt : 1u;
}

__device__ __forceinline__ void xcd_barrier(const XcdBarrier& b) {
    asm volatile("s_waitcnt vmcnt(0)" ::: "memory");
    __syncthreads();
    if (b.t0) {
        unsigned* bar = b.bar;
        __builtin_amdgcn_s_waitcnt(0);
        unsigned nloc = b.st[0], nx = b.st[1];
        if (nloc == 0u) { xcd_barrier_complete(bar, b.x, nloc, nx); b.st[0] = nloc; b.st[1] = nx; }
        const unsigned old = xb_add(&bar[XB_XSUB(b.x)], 1u);
        const unsigned gen = old / nloc;
        if (old + 1u == (gen + 1u) * nloc) {
            __builtin_amdgcn_fence(__ATOMIC_RELEASE, "agent");
            asm volatile("s_waitcnt vmcnt(0)" ::: "memory");
            const unsigned og = xb_add(&bar[XB_TOP], 1u);
            const unsigned tg = og / nx;
            if (og + 1u == (tg + 1u) * nx) xb_add(&bar[XB_TOPGEN], 1u);
            else XB_SPIN(xb_ld(&bar[XB_TOPGEN]) == tg, bar);
            __builtin_amdgcn_fence(__ATOMIC_ACQUIRE, "agent");
            xb_add(&bar[XB_XGEN(b.x)], 1u);
            asm volatile("s_waitcnt vmcnt(0)" ::: "memory");
        } else {
            XB_SPIN(xb_ld(&bar[XB_XGEN(b.x)]) == gen, bar);
            __builtin_amdgcn_fence(__ATOMIC_ACQUIRE, "agent");
            asm volatile("s_waitcnt vmcnt(0)" ::: "memory");
        }
    }
    __syncthreads();
}

#define OPQ_S(x) asm volatile("" : "+s"(x))
#define OPQ_V(x) asm volatile("" : "+v"(x))
#define PHASE_VARS() unsigned char* ws = opq_global(args.ws); int tid = tid_now(wave_s); const int lane = tid & 63, wave = wave_s; \
    const int G = gridDim.x, bx = blockIdx.x, gw = bx * NWAVES + wave, NGW = G * NWAVES; (void)lane; (void)gw; (void)NGW; (void)ws
__global__ void __launch_bounds__(NWAVES * 64, 2) fwd(Args args) {
    extern __shared__ __attribute__((aligned(16))) unsigned char lds_raw[];
    LAS unsigned char* lds = (LAS unsigned char*)lds_raw;
    const int lo = args.ph_lo, hi = args.ph_hi;
#define IN(k) (lo <= (k) && (k) < hi)
#define PHASE_BEGIN(k, REP) if (IN(k)) { PHASE_VARS();
#define PHASE_END(k, REP) if (BOTH(k)) GRID_BAR(); }
#define BOTH(k) (IN(k) && IN((k) + 1))
#define GRID_BAR() do { XcdBarrier b_; b_.t0 = tid_now(wave_s) == 0; b_.bar = (unsigned*)(ws + WS_CTL) + CW_BAR; b_.x = xb_xcc_id(); b_.st = (volatile LAS unsigned*)(lds + MISC_OFF); xcd_barrier(b_); } while (0)
    const int wave_s = __builtin_amdgcn_readfirstlane(threadIdx.x >> 6);
    if (threadIdx.x < 64) ((LAS unsigned*)(lds + MISC_OFF))[threadIdx.x] = 0u;
    __syncthreads();
    if (hi - lo > 1) (void)xcd_barrier_post((unsigned*)(args.ws + WS_CTL) + CW_BAR, (volatile LAS unsigned*)(lds + MISC_OFF));

    PHASE_BEGIN(0, 1)
        float* CS = (float*)(ws + WS_CS);
        convert_all(args, ws, 0, CONV_IN_TAILS ? I_IN : DEPTH * I_L, gw, NGW, (LAS float*)(lds + wave * 16640), lane);
#if PROBE_WRITES
        { for (int it = gw; it < DEPTH * I_L; it += NGW) { ConvItem cc = conv_item(args, ws, it);
              const int nblk = cc.N / 64, k0 = 64 * (cc.r / nblk), n0 = 64 * (cc.r % nblk), K = cc.K; const int c = lane & 7;
              const size_t base = ((size_t)((const unsigned char*)cc.WT - (ws + WS_WIN))) & (size_t)(128 * MiB - 1);
#pragma unroll
              for (int j = 0; j < 8; ++j) { const int n = (lane >> 3) + 8 * j; v4u o; o.x = it; o.y = j; o.z = lane; o.w = 0;
                  const size_t off = (base + ((size_t)(n0 + n) * K + k0 + 8 * c) * 2) & (size_t)(128 * MiB - 1);
                  *(v4u*)(ws + WS_ZB + off) = o; } } }
#endif
        cast_phase(GIN(0), (bf16*)(ws + WS_H), (float*)(ws + WS_SSQ), gw, NGW, lane);
        for (int i = bx * 512 + tid; i < SEQ * 64; i += G * 512) { const int pos = i >> 6, k = i & 63; const float inv = powf(10000.0f, -(float)k / 64.0f); const float ang = (float)pos * inv;
            CS[2 * i] = cosf(ang); CS[2 * i + 1] = sinf(ang); }
    PHASE_END(0, 1)

    for (int l = 0; l < DEPTH; ++l) {
        const int pb = 1 + l * NPH;
        PHASE_BEGIN(pb + PH_GEMM1, 1)
            pg8::Gemm g{}; g.wave_s = wave_s; g.A = (const bf16*)(ws + WS_H); g.Bt = (const bf16*)(ws + WS_WIN) + (size_t)l * D_IN * D_MODEL; g.M = M; g.N = D_IN; g.K = D_MODEL;
            deal_table(lds, M, D_IN, G, bx, tid);
            pg8::ListOrder S; S.tab = (LAS const int*)(lds + MISC_OFF + 128);
#pragma unroll 1
            for (int rep_ = 0; rep_ < REP_G1; ++rep_) {
            if (rep_) __syncthreads();
            rs_prepare(S, (const float*)(ws + WS_SSQ), (LAS float*)(lds + RS_OFF), 0, tid);
            pg8::Epi1 E; E.rs = (LAS const float*)(lds + RS_OFF); E.ZB = (bf16*)(ws + WS_ZB); E.qg = GIN(5) + l * HD; E.kg = GIN(6) + l * HD; E.cs = (const float*)(ws + WS_CS); E.xch = (LAS float*)(lds + XCH_OFF);
            if (CONV_IN_TAILS) { const int cr = __builtin_amdgcn_readfirstlane(S.tab[16]), nc = __builtin_amdgcn_readfirstlane(S.tab[17]);
                if (cr >= 0) convert_all(args, ws, l * I_L + I_IN, l * I_L + I_IN + I_BR + I_O + I_UP, cr * NWAVES + wave, nc * NWAVES, (LAS float*)(lds + wave * 16640), lane);
                __syncthreads(); }
            pg8::gemm_phase<pg8::Epi1, pg8::ListOrder, true, true>(lds + RING_OFF, g, S, E);
            }
            PHASE_END(pb + PH_GEMM1, 1)
        PHASE_BEGIN(pb + PH_MIX, 1)
            state_phase(lds, ws, (unsigned)(l + 1), bx, G, tid);
            { unsigned char* ws2 = opq_global(args.ws); int tid2 = tid_now(wave_s); mix_phase(lds, ws2, (unsigned)(l + 1), GIN(7), GIN(8) + l * HD, bx, G, tid2); }
            PHASE_END(pb + PH_MIX, 1)
        PHASE_BEGIN(pb + PH_BR, 1)
            pg8::Gemm g{}; g.wave_s = wave_s; g.A = (const bf16*)(ws + WS_YAR); g.Bt = (const bf16*)(ws + WS_WBR) + (size_t)(2 * l) * D_MODEL * AW; g.M = 2 * M; g.N = 2 * D_MODEL; g.K = AW;
            pg8::BranchOrder S; S.init(G, bx);
            pg8::EpiBr E; E.ZB = (const bf16*)(ws + WS_ZB); E.MRG = (bf16*)(ws + WS_MRG);
            pg8::gemm_phase<pg8::EpiBr, pg8::BranchOrder, true, true>(lds + RING_OFF, g, S, E);
            PHASE_END(pb + PH_BR, 1)
        PHASE_BEGIN(pb + PH_WO, 1)
            pg8::Gemm g{}; g.wave_s = wave_s; g.A = (const bf16*)(ws + WS_MRG); g.Bt = (const bf16*)(ws + WS_WO) + (size_t)l * D_MODEL * D_MODEL; g.M = M; g.N = D_MODEL; g.K = D_MODEL;
            pg8::StaticOrder S; S.init(M, D_MODEL, G, bx);
            pg8::EpiRes E; E.x32 = l == 0 ? GIN(0) : nullptr; E.out32 = nullptr; E.XB = (bf16*)(ws + WS_H); E.SSQ = (float*)(ws + WS_SSQ);
            pg8::gemm_phase<pg8::EpiRes, pg8::StaticOrder, true, true>(lds + RING_OFF, g, S, E);
            PHASE_END(pb + PH_WO, 1)
        PHASE_BEGIN(pb + PH_UP, 1)
            pg8::Gemm g{}; g.wave_s = wave_s; g.A = (const bf16*)(ws + WS_H) - 2 * D_MODEL; g.Bt = (const bf16*)(ws + WS_WUP) + (size_t)l * D_IN * D_MODEL; g.M = 33 * 256; g.N = D_IN; g.K = D_MODEL; g.a_rows = 254;
            deal_table(lds, 33 * 256, D_IN, G, bx, tid);
            pg8::ListOrder S; S.tab = (LAS const int*)(lds + MISC_OFF + 128);
#pragma unroll 1
            for (int rep_ = 0; rep_ < REP_UP; ++rep_) {
            if (rep_) __syncthreads();
            rs_prepare(S, (const float*)(ws + WS_SSQ), (LAS float*)(lds + RS_OFF), 254, tid);
            pg8::EpiUC E; E.rs = (LAS const float*)(lds + RS_OFF); E.ACT = (bf16*)(ws + WS_ACT); E.cw = GIN(11) + (size_t)l * 3 * 2 * D_FF; E.cb = GIN(12) + (size_t)l * 2 * D_FF; E.xch = (LAS float*)(lds + XCH_OFF);
            if (CONV_IN_TAILS) { const int cr = __builtin_amdgcn_readfirstlane(S.tab[16]), nc = __builtin_amdgcn_readfirstlane(S.tab[17]);
                if (cr >= 0) convert_all(args, ws, l * I_L + I_IN + I_BR + I_O + I_UP, l + 1 < DEPTH ? (l + 1) * I_L + I_IN : (l + 1) * I_L, cr * NWAVES + wave, nc * NWAVES, (LAS float*)(lds + wave * 16640), lane);
                __syncthreads(); }
            pg8::gemm_phase<pg8::EpiUC, pg8::ListOrder, true, true>(lds + RING_OFF, g, S, E);
            }
            PHASE_END(pb + PH_UP, 1)
        PHASE_BEGIN(pb + PH_DOWN, 1)
            pg8::Gemm g{}; g.wave_s = wave_s; g.A = (const bf16*)(ws + WS_ACT); g.Bt = (const bf16*)(ws + WS_WDN) + (size_t)l * D_MODEL * D_FF; g.M = M; g.N = D_MODEL; g.K = D_FF;
            pg8::StaticOrder S; S.init(M, D_MODEL, G, bx);
            pg8::EpiRes E; E.x32 = nullptr; E.out32 = (l == DEPTH - 1) ? args.out : nullptr; E.XB = (bf16*)(ws + WS_H); E.SSQ = (float*)(ws + WS_SSQ);
            pg8::gemm_phase<pg8::EpiRes, pg8::StaticOrder, true, true>(lds + RING_OFF, g, S, E);
            PHASE_END(pb + PH_DOWN, 1)
    }
#undef IN
#undef BOTH
}

extern "C" void kernel_launch(void* const* d_in, const int* in_sizes, int n_in, void* d_out, int out_size, void* d_ws, size_t ws_size, hipStream_t stream) {
    static int grid = 0;
    if (grid == 0) {
        if (n_in != 14 || ws_size < WS_END || out_size != M * D_MODEL) { fprintf(stderr, "kernel_launch: bad inputs (n_in %d, ws %zu < %zu, out %d)\n", n_in, ws_size, (size_t)WS_END, out_size); grid = -1; return; }
        int dev = 0, cus = 0;
        if (hipGetDevice(&dev) != hipSuccess || hipDeviceGetAttribute(&cus, hipDeviceAttributeMultiprocessorCount, dev) != hipSuccess) { grid = -1; return; }
        if (hipFuncSetAttribute((const void*)fwd, hipFuncAttributeMaxDynamicSharedMemorySize, LDS_BYTES) != hipSuccess) { fprintf(stderr, "kernel_launch: hipFuncSetAttribute failed\n"); grid = -1; return; }
        if (cus < 242) { fprintf(stderr, "kernel_launch: %d CUs < 242 (the rstd table holds 6 units per workgroup)\n", cus); grid = -1; return; }
        grid = cus;
    }
    if (grid < 0) return;
    (void)hipMemsetAsync((char*)d_ws + WS_CTL, 0, CTL_ZERO_BYTES, stream);
    Args a{};
    for (int i = 0; i < 14; ++i) a.in[i] = (const float*)d_in[i];
    a.out = (float*)d_out; a.ws = (unsigned char*)d_ws;
    if (ONE_LAUNCH) { a.ph_lo = 0; a.ph_hi = N_PHASES; hipLaunchKernelGGL(fwd, dim3(grid), dim3(NWAVES * 64), LDS_BYTES, stream, a); }
    else for (int ph = 0; ph < N_PHASES; ++ph) { const int nrep = (ph > 0 && (ph - 1) % NPH == PROBE_PH) ? PROBE_N : 1;
        for (int r = 0; r < nrep; ++r) { a.ph_lo = ph; a.ph_hi = ph + 1; hipLaunchKernelGGL(fwd, dim3(grid), dim3(NWAVES * 64), LDS_BYTES, stream, a); } }
}
```

```cpp
#include <hip/hip_runtime.h>
#include <cstdio>
#include <cstdint>
#include <type_traits>
namespace pg8 {
#define PG8_LAS __attribute__((address_space(3)))
typedef unsigned short bf16_t;
typedef short bf16x8 __attribute__((ext_vector_type(8)));
typedef float f32x4 __attribute__((ext_vector_type(4)));
typedef unsigned u32x4 __attribute__((ext_vector_type(4)));
constexpr int BM = 256, BK = 64, HALF = 128, HTB = HALF * BK * 2  , STAGE_BYTES = 8 * HTB, NXCD = 8, WGM = 8;

__host__ __device__ __forceinline__ int lds_byte(int r, int c) { const int st = (r >> 4) * 2 + (c >> 5), rr = r & 15, cc = c & 31, ob = rr * 64 + cc * 2; return st * 1024 + (ob ^ (((ob >> 9) & 1) << 5)); }
__host__ __device__ __forceinline__ void stage_rc(int b, int& R, int& C) { const int st = b / 1024, sb = b % 1024, swz = sb ^ (((sb >> 9) & 1) << 5); R = (st >> 1) * 16 + swz / 64; C = (st & 1) * 32 + (swz % 64) / 2; }
__host__ __device__ __forceinline__ int perm32(int rho) { const int n = rho >> 4, i = rho & 15; return 8 * (i >> 2) + 4 * n + (i & 3); }

struct Unit { int pm, pn; };
struct Gemm { const bf16_t* A; const bf16_t* Bt; int M, N, K, a_rows, wave_s; };

struct StaticOrder {
    int nM, nN, nwg, G, c;
    __host__ __device__ void init(int M, int N, int G_, int c_) { nM = M / BM; nN = N / BM; nwg = nM * nN; G = G_; c = c_; }
    __host__ __device__ __forceinline__ bool next(int i, Unit& u) const {
        const long L = (long)i * G + c; if (L >= nwg) return false;
        int wgid = (int)L; { const int q = nwg / NXCD, r = nwg % NXCD, xcd = wgid % NXCD, off = wgid / NXCD; wgid = (xcd < r ? xcd * (q + 1) : r * (q + 1) + (xcd - r) * q) + off; }
        const int nig = WGM * nN, gid = wgid / nig, fm = gid * WGM, gsz = (nM - fm) < WGM ? (nM - fm) : WGM;
        u.pm = fm + ((wgid % nig) % gsz); u.pn = (wgid % nig) / gsz; return true;
    }
    __device__ __forceinline__ void a_ready(const Unit&) const {}
    __device__ __forceinline__ void done(const Unit&) const {}
};
struct DealOrder {
    StaticOrder so; int nv, kv, R;
    __device__ __forceinline__ void init(int M, int N, int G, int c, int nv_, int kv_) { so.init(M, N, G, c); nv = nv_; kv = kv_; const int nonv = G - nv_; R = (so.nwg - nv_ * kv_ + nonv - 1) / nonv;
        const int left = (R - 1 - kv_) * nv_ + (so.nwg - (R - 1) * G);
        if (nv_ <= 0 || R - 1 < kv_ || (long)(R - 1) * G > so.nwg || left > nonv) { nv = 0; kv = 0; R = (so.nwg + G - 1) / G; } }
    __device__ __forceinline__ bool at(long L, Unit& u) const { if (L >= so.nwg) return false; StaticOrder t = so; t.c = 0; t.G = 1; return t.next((int)L, u); }
    __device__ __forceinline__ bool next(int i, Unit& u) const {
        if (!nv) return so.next(i, u);
        const int G = so.G, c = so.c, nonv = G - nv;
        if (c >= nonv) return i < kv && at((long)i * G + c, u);
        if (i < R - 1) return at((long)i * G + c, u);
        if (i > R - 1) return false;
        const int nfree = (R - 1 - kv) * nv;
        return c < nfree ? at((long)(kv + c / nv) * G + nonv + c % nv, u) : at((long)(R - 1) * G + (c - nfree), u);
    }
    __device__ __forceinline__ bool converts() const { return nv && so.c >= so.G - nv; }
    __device__ __forceinline__ void a_ready(const Unit&) const {}
    __device__ __forceinline__ void done(const Unit&) const {}
};
struct XcdDeal {
    StaticOrder so; int R, G8, nlong, base, conv_rank, nconv, j;
    __device__ __forceinline__ void init(int M, int N, int G, int c) { so.init(M, N, G, c); G8 = G / 8; R = (so.nwg + G - 1) / G; const int full = so.nwg - (R - 1) * G;
        const int x = c % 8; j = c / 8; base = 0; int crank = 0;
        for (int y = 0; y < x; ++y) { int ly = full - G8 * y; ly = ly < 0 ? 0 : ly > G8 ? G8 : ly; base += (R - 1) * G8 + ly; crank += G8 - ly; }
        nlong = full - G8 * x; nlong = nlong < 0 ? 0 : nlong > G8 ? G8 : nlong; conv_rank = j >= nlong ? crank + (j - nlong) : -1; nconv = G - full; }
    __device__ __forceinline__ bool next(int i, Unit& u) const {
        if (i >= (j < nlong ? R : R - 1)) return false;
        const int wgid = base + i * G8 + j; if (wgid >= so.nwg) return false;
        const int nig = WGM * so.nN, gid = wgid / nig, fm = gid * WGM, gsz = (so.nM - fm) < WGM ? (so.nM - fm) : WGM;
        u.pm = fm + ((wgid % nig) % gsz); u.pn = (wgid % nig) / gsz; return true;
    }
};
struct ListOrder {
    PG8_LAS const int* tab;
    __device__ __forceinline__ bool next(int i, Unit& u) const { if (i >= 8) return false; const int pm = __builtin_amdgcn_readfirstlane(tab[2 * i]); if (pm < 0) return false; u.pm = pm; u.pn = __builtin_amdgcn_readfirstlane(tab[2 * i + 1]); return true; }
    __device__ __forceinline__ void a_ready(const Unit&) const {}
    __device__ __forceinline__ void done(const Unit&) const {}
};
#define GAS __attribute__((address_space(1)))
__device__ __forceinline__ unsigned cvt_pk_bf16(float lo, float hi) { unsigned r; asm volatile("v_cvt_pk_bf16_f32 %0, %1, %2" : "=v"(r) : "v"(lo), "v"(hi)); return r; }
typedef float f32x2 __attribute__((ext_vector_type(2)));
typedef unsigned u32x2 __attribute__((ext_vector_type(2)));
__device__ __forceinline__ f32x4 bf_lo4(u32x4 w) { return (f32x4){__uint_as_float(w.x << 16), __uint_as_float(w.x & 0xffff0000u), __uint_as_float(w.y << 16), __uint_as_float(w.y & 0xffff0000u)}; }
__device__ __forceinline__ f32x4 bf_hi4(u32x4 w) { return (f32x4){__uint_as_float(w.z << 16), __uint_as_float(w.z & 0xffff0000u), __uint_as_float(w.w << 16), __uint_as_float(w.w & 0xffff0000u)}; }
__device__ __forceinline__ u32x4 pack8(f32x4 a, f32x4 b) { u32x4 w; w.x = cvt_pk_bf16(a[0], a[1]); w.y = cvt_pk_bf16(a[2], a[3]); w.z = cvt_pk_bf16(b[0], b[1]); w.w = cvt_pk_bf16(b[2], b[3]); return w; }
__device__ __forceinline__ u32x2 pack4(f32x4 a) { u32x2 w; w.x = cvt_pk_bf16(a[0], a[1]); w.y = cvt_pk_bf16(a[2], a[3]); return w; }
__device__ __forceinline__ f32x2 gelu_pk(f32x2 v) {
    const f32x2 av = __builtin_elementwise_abs(v), d = av * 0.2316418882f + 1.0f;
    f32x2 t; t.x = __builtin_amdgcn_rcpf(d.x); t.y = __builtin_amdgcn_rcpf(d.y);
    f32x2 q = t * 0.5307027145f + (-0.7265760135f); q = q * t + 0.7107068705f; q = q * t + (-0.142248368f); q = q * t + 0.127414796f; q = q * t;
    const f32x2 s = (v * v) * (-0.72134752044f);
    f32x2 e; e.x = __builtin_amdgcn_exp2f(s.x); e.y = __builtin_amdgcn_exp2f(s.y);
    const f32x2 h = 0.5f - q * e;
    return av * h + v * 0.5f;
}
__device__ __forceinline__ float sigmoidf_(float x) { return __builtin_amdgcn_rcpf(1.0f + __builtin_amdgcn_exp2f(-1.4426950408889634f * x)); }

#ifndef NT_STORES
#define NT_STORES 0
#endif
#if NT_STORES
#define ST_BIG(p, v) __builtin_nontemporal_store((v), (p))
#else
#define ST_BIG(p, v) (*(p) = (v))
#endif
__device__ __forceinline__ float lg2_gamma(int h) { const float e = __builtin_ldexpf(1.0f, -5 - h);
    return -1.4426950408889634f * e * (1.0f + e * (0.5f + e * (0.3333333333f + e * (0.25f + e * (0.2f + e * 0.1666666667f))))); }
constexpr size_t ZSEC = (size_t)8192 * 1024;
struct Epi1 {
    static constexpr bool PERM = true, AFTER_DRAIN = false, ROWSCALE = true;
    PG8_LAS const float* rs; bf16_t* ZB; const float* qg; const float* kg; const float* cs; PG8_LAS float* xch;
    __device__ __forceinline__ void operator()(const f32x4 (&acc)[2][2][4][2], const Unit& u, int wr, int wc, int fr, int fq) const {
        const int sec = u.pn >> 2; const int rowl0 = wr * 64 + fr; const size_t LD = 1024;
        bf16_t* zb0 = ZB + (size_t)sec * ZSEC + (size_t)(u.pm * BM + rowl0) * LD + (u.pn & 3) * BM + wc * 32 + 8 * fq;
        if (sec <= 1) {
#pragma unroll
            for (int ai = 0; ai < 2; ++ai)
#pragma unroll
                for (int m = 0; m < 4; ++m)
#pragma unroll
                    for (int bj = 0; bj < 2; ++bj) { const f32x4 a = acc[ai][bj][m][0], b = acc[ai][bj][m][1];
                        float s = (a[0] * a[0] + a[1] * a[1]) + (a[2] * a[2] + a[3] * a[3]) + (b[0] * b[0] + b[1] * b[1]) + (b[2] * b[2] + b[3] * b[3]);
                        { auto r16 = __builtin_amdgcn_permlane16_swap(__float_as_uint(s), __float_as_uint(s), false, false); s = __uint_as_float(r16[0]) + __uint_as_float(r16[1]); auto r32 = __builtin_amdgcn_permlane32_swap(__float_as_uint(s), __float_as_uint(s), false, false); s = __uint_as_float(r32[0]) + __uint_as_float(r32[1]); }
                        if (fq == 0) xch[((ai * HALF + rowl0 + m * 16) * 2 + bj) * 4 + wc] = s; }
            asm volatile("s_waitcnt lgkmcnt(0)" ::: "memory"); __builtin_amdgcn_s_barrier(); asm volatile("" ::: "memory");
            const float* g = (sec == 0 ? qg : kg) + wc * 32 + 8 * fq; const float gs = sec == 0 ? 0.08838834764831845f * 1.4426950408889634f : 1.0f;
            const f32x4 g0 = *(const f32x4*)g * gs, g1 = *(const f32x4*)(g + 4) * gs;
#pragma unroll
            for (int ai = 0; ai < 2; ++ai)
#pragma unroll
                for (int m = 0; m < 4; ++m)
#pragma unroll
                    for (int bj = 0; bj < 2; ++bj) { const f32x4 p = *(const PG8_LAS f32x4*)(xch + ((ai * HALF + rowl0 + m * 16) * 2 + bj) * 4);
                        const float r = 1.0f / sqrtf(((p[0] + p[1]) + (p[2] + p[3])) * (1.0f / 128.0f) + 1e-6f);
                        ST_BIG((u32x4*)(zb0 + (size_t)(ai * HALF + m * 16) * LD + bj * HALF), pack8(acc[ai][bj][m][0] * r * g0, acc[ai][bj][m][1] * r * g1)); }
        } else if (sec == 3 || sec == 4) {
            const int hd = wc >> 1, i0 = 32 * (wc & 1) + 8 * fq; bf16_t* zr0 = ZB + (size_t)sec * ZSEC + (size_t)(u.pm * BM + rowl0) * LD + (u.pn & 3) * BM + hd * 128 + i0;
            const float lg2 = lg2_gamma((u.pn & 3) * 2 + hd);
            f32x4 ct[2][2][4];
#define RO_LOAD(q, B) do { _Pragma("unroll") for (int mm = 0; mm < 2; ++mm) { const int pos = (u.pm * BM + rowl0 + ((q) >> 1) * HALF + (2 * ((q) & 1) + mm) * 16) & 2047; const float* cp = cs + (size_t)pos * 128 + 2 * i0; \
                _Pragma("unroll") for (int k = 0; k < 4; ++k) ct[B][mm][k] = *(const f32x4*)(cp + 4 * k); } } while (0)
            RO_LOAD(0, 0);
#pragma unroll
            for (int q = 0; q < 4; ++q) { const int B = q & 1, ai = q >> 1;
                if (q < 3) { if (B) RO_LOAD(q + 1, 0); else RO_LOAD(q + 1, 1); }
                __builtin_amdgcn_sched_barrier(0);
#pragma unroll
                for (int mm = 0; mm < 2; ++mm) { const int m = 2 * (q & 1) + mm; const int pos = (u.pm * BM + rowl0 + ai * HALF + m * 16) & 2047;
                    const f32x4 c0 = ct[B][mm][0], c1 = ct[B][mm][1], c2 = ct[B][mm][2], c3 = ct[B][mm][3];
                    const f32x4 cva = (f32x4){c0[0], c0[2], c1[0], c1[2]}, sva = (f32x4){c0[1], c0[3], c1[1], c1[3]}, cvb = (f32x4){c2[0], c2[2], c3[0], c3[2]}, svb = (f32x4){c2[1], c2[3], c3[1], c3[3]};
                    const float sc = sec == 3 ? __builtin_amdgcn_exp2f(lg2 * (float)(pos & 63)) : 0.08838834764831845f * __builtin_amdgcn_exp2f(-lg2 * (float)(pos & 63));
                    const f32x4 x1a = acc[ai][0][m][0], x1b = acc[ai][0][m][1], x2a = acc[ai][1][m][0], x2b = acc[ai][1][m][1];
                    bf16_t* o = zr0 + (size_t)(ai * HALF + m * 16) * LD;
                    ST_BIG((u32x4*)o, pack8((x1a * cva - x2a * sva) * sc, (x1b * cvb - x2b * svb) * sc)); ST_BIG((u32x4*)(o + 64), pack8((x1a * sva + x2a * cva) * sc, (x1b * svb + x2b * cvb) * sc)); }
                __builtin_amdgcn_sched_barrier(0);
            }
#undef RO_LOAD
        } else {
#pragma unroll
            for (int ai = 0; ai < 2; ++ai)
#pragma unroll
                for (int m = 0; m < 4; ++m)
#pragma unroll
                    for (int bj = 0; bj < 2; ++bj) { f32x4 a = acc[ai][bj][m][0], b = acc[ai][bj][m][1];
                        if (sec >= 6) {
#pragma unroll
                            for (int j = 0; j < 4; ++j) { const float sa = sigmoidf_(a[j]), sb = sigmoidf_(b[j]); a[j] = sec == 6 ? a[j] * sa : sa; b[j] = sec == 6 ? b[j] * sb : sb; } }
                        ST_BIG((u32x4*)(zb0 + (size_t)(ai * HALF + m * 16) * LD + bj * HALF), pack8(a, b)); }
        }
    }
};

struct EpiBr {
    static constexpr bool PERM = true, AFTER_DRAIN = false, ROWSCALE = false;
    const bf16_t* ZB; bf16_t* MRG;
    template <int BR> __device__ __forceinline__ void run(const f32x4 (&acc)[2][2][4][2], int row0, int col0) const {
        const size_t LD = 1024;
        u32x4 gw[2][2][2], tw[2][2][2];
#define EBR_LOAD(q, B) do { _Pragma("unroll") for (int mm = 0; mm < 2; ++mm) _Pragma("unroll") for (int bj = 0; bj < 2; ++bj) { \
            const size_t row = (size_t)(row0 + ((q) >> 1) * HALF + (2 * ((q) & 1) + mm) * 16); const int col = col0 + bj * HALF; \
            gw[B][mm][bj] = *(const u32x4*)(ZB + (size_t)(7 + 2 * BR + (col >> 10)) * ZSEC + row * LD + (col & 1023)); \
            if (BR) tw[B][mm][bj] = *(const u32x4*)(MRG + row * 2048 + col); } } while (0)
        EBR_LOAD(0, 0);
#pragma unroll
        for (int q = 0; q < 4; ++q) { const int B = q & 1;
            if (q < 3) { if (B) EBR_LOAD(q + 1, 0); else EBR_LOAD(q + 1, 1); }
            __builtin_amdgcn_sched_barrier(0);
#pragma unroll
            for (int mm = 0; mm < 2; ++mm)
#pragma unroll
                for (int bj = 0; bj < 2; ++bj) { const int ai = q >> 1, m = 2 * (q & 1) + mm; const size_t row = (size_t)(row0 + ai * HALF + m * 16); const int col = col0 + bj * HALF;
                    const f32x4 a = acc[ai][bj][m][0] * bf_lo4(gw[B][mm][bj]), b = acc[ai][bj][m][1] * bf_hi4(gw[B][mm][bj]);
                    bf16_t* t = MRG + row * 2048 + col;
                    if (BR == 0) *(u32x4*)t = pack8(a, b);
                    else *(u32x4*)t = pack8(bf_lo4(tw[B][mm][bj]) + a, bf_hi4(tw[B][mm][bj]) + b); }
            __builtin_amdgcn_sched_barrier(0);
        }
#undef EBR_LOAD
    }
    __device__ __forceinline__ void operator()(const f32x4 (&acc)[2][2][4][2], const Unit& u, int wr, int wc, int fr, int fq) const {
        const int br = u.pm >> 5, pm = u.pm & 31, pn = u.pn & 7;
        const int row0 = pm * BM + wr * 64 + fr, col0 = pn * BM + wc * 32 + 8 * fq;
        if (br) run<1>(acc, row0, col0); else run<0>(acc, row0, col0);
    }
};

struct EpiRes {
    static constexpr bool SKIPHI = false; static constexpr bool PERM = true, AFTER_DRAIN = false, ROWSCALE = false;
    const float* x32; float* out32; bf16_t* XB; float* SSQ;
    template <int IN32, int OUT32> __device__ __forceinline__ void run(const f32x4 (&acc)[2][2][4][2], int pn, int row0, int col0, int wc, int fq) const {
        f32x4 xa[2][2][2][2]; u32x4 xq[2][2][2];
#define ER_LOAD(q, B) do { _Pragma("unroll") for (int mm = 0; mm < 2; ++mm) _Pragma("unroll") for (int bj = 0; bj < 2; ++bj) { \
            const size_t off = (size_t)(row0 + ((q) >> 1) * HALF + (2 * ((q) & 1) + mm) * 16) * 2048 + col0 + bj * HALF; \
            if (IN32) { xa[B][mm][bj][0] = *(const f32x4*)(x32 + off); xa[B][mm][bj][1] = *(const f32x4*)(x32 + off + 4); } else xq[B][mm][bj] = *(const u32x4*)(XB + off); } } while (0)
        ER_LOAD(0, 0);
#pragma unroll
        for (int q = 0; q < 4; ++q) { const int B = q & 1;
            if (q < 3) { if (B) ER_LOAD(q + 1, 0); else ER_LOAD(q + 1, 1); }
            __builtin_amdgcn_sched_barrier(0);
#pragma unroll
            for (int mm = 0; mm < 2; ++mm) { const int ai = q >> 1, m = 2 * (q & 1) + mm, row = row0 + ai * HALF + m * 16; const size_t off = (size_t)row * 2048 + col0; float s = 0.f;
#pragma unroll
                for (int bj = 0; bj < 2; ++bj) { const f32x4 x0 = IN32 ? xa[B][mm][bj][0] : bf_lo4(xq[B][mm][bj]), x1 = IN32 ? xa[B][mm][bj][1] : bf_hi4(xq[B][mm][bj]);
                    const f32x4 y0 = x0 + acc[ai][bj][m][0], y1 = x1 + acc[ai][bj][m][1];
                    if (OUT32) { *(f32x4*)(out32 + off + bj * HALF) = y0; *(f32x4*)(out32 + off + bj * HALF + 4) = y1; }
                    else { *(u32x4*)(XB + off + bj * HALF) = pack8(y0, y1);
                        s += ((y0[0] * y0[0] + y0[1] * y0[1]) + (y0[2] * y0[2] + y0[3] * y0[3])) + ((y1[0] * y1[0] + y1[1] * y1[1]) + (y1[2] * y1[2] + y1[3] * y1[3])); } }
                if (!OUT32) { auto r16 = __builtin_amdgcn_permlane16_swap(__float_as_uint(s), __float_as_uint(s), false, false); s = __uint_as_float(r16[0]) + __uint_as_float(r16[1]);
                    auto r32 = __builtin_amdgcn_permlane32_swap(__float_as_uint(s), __float_as_uint(s), false, false); s = __uint_as_float(r32[0]) + __uint_as_float(r32[1]);
                    if (fq == 0) SSQ[(size_t)row * 32 + pn * 4 + wc] = s; } }
            __builtin_amdgcn_sched_barrier(0);
        }
#undef ER_LOAD
    }
    __device__ __forceinline__ void operator()(const f32x4 (&acc)[2][2][4][2], const Unit& u, int wr, int wc, int fr, int fq) const {
        const int row0 = u.pm * BM + wr * 64 + fr, col0 = u.pn * BM + wc * 32 + 8 * fq;
        if (x32) run<1, 0>(acc, u.pn, row0, col0, wc, fq); else if (out32) run<0, 1>(acc, u.pn, row0, col0, wc, fq); else run<0, 0>(acc, u.pn, row0, col0, wc, fq);
    }
};

__device__ __forceinline__ float dpp_ror1(float v) { return __uint_as_float(__builtin_amdgcn_update_dpp(0u, __float_as_uint(v), 0x121, 0xf, 0xf, true)); }
__device__ __forceinline__ float dpp_ror2(float v) { return __uint_as_float(__builtin_amdgcn_update_dpp(0u, __float_as_uint(v), 0x122, 0xf, 0xf, true)); }
struct EpiUC {
    static constexpr bool PERM = true, AFTER_DRAIN = false, ROWSCALE = true;
    PG8_LAS const float* rs; bf16_t* ACT; const float* cw; const float* cb; PG8_LAS float* xch;
    __device__ __forceinline__ void operator()(const f32x4 (&acc)[2][2][4][2], const Unit& u, int wr, int wc, int fr, int fq) const {
        const int R0 = 254 * u.pm - 2, ch = 128 * u.pn + 32 * wc + 8 * fq;
#pragma unroll
        for (int ai = 0; ai < 2; ++ai)
            if (fr >= 14) { PG8_LAS f32x4* d = (PG8_LAS f32x4*)(xch + ((((ai * 2 + wr) * 4 + wc) * 4 + fq) * 2 + (fr - 14)) * 16);
                d[0] = acc[ai][0][3][0]; d[1] = acc[ai][0][3][1]; d[2] = acc[ai][1][3][0]; d[3] = acc[ai][1][3][1]; }
        { const int e2 = 2 * (((wr * 4 + wc) * 4 + fq) * 16 + fr), kind = e2 >> 8, ci = ((e2 >> 7) & 1) * 5632 + 128 * u.pn + (e2 & 127);
          *(PG8_LAS f32x2*)(xch + 2048 + e2) = *(GAS const f32x2*)(kind < 3 ? cw + kind * 11264 + ci : cb + ci); }
        asm volatile("s_waitcnt lgkmcnt(0)" ::: "memory"); __builtin_amdgcn_s_barrier(); asm volatile("" ::: "memory");
        PG8_LAS const float* cl = xch + 2048 + 32 * wc + 8 * fq;
#pragma unroll
        for (int ai = 0; ai < 2; ++ai) {
            PG8_LAS const float* hb; { const int sai = wr ? ai : ai - 1, swr = wr ? 0 : 1; hb = xch + ((((sai * 2 + swr) * 4 + wc) * 4 + fq) * 2 + (fr - 14)) * 16; asm volatile("" : "+v"(hb)); }
            const int s0 = (R0 + ai * HALF + wr * 64) & 2047; const bool tail = s0 >= 1984;
            u32x2 held[4];
#pragma unroll
            for (int n = 0; n < 2; ++n) {
                f32x4 gl[4];
#pragma unroll
                for (int bj = 0; bj < 2; ++bj) {
                    const int c = bj * 128 + 4 * n;
                    const f32x4 w0 = *(PG8_LAS const f32x4*)(cl + c), w1 = *(PG8_LAS const f32x4*)(cl + 256 + c), w2 = *(PG8_LAS const f32x4*)(cl + 512 + c), bs = *(PG8_LAS const f32x4*)(cl + 768 + c);
                    f32x4 q1, q2;
                    { f32x4 hv = (f32x4){0.f, 0.f, 0.f, 0.f};
                      if ((ai | wr) && s0 != 0 && fr >= 14) hv = *(const PG8_LAS f32x4*)(hb + (2 * bj + n) * 4);
                      q1 = w1 * hv; q2 = w0 * hv; }
#pragma unroll
                    for (int m = 0; m < 4; ++m) { const int rho = ai * HALF + wr * 64 + m * 16 + fr, grow = R0 + rho;
                        const f32x4 cur = acc[ai][bj][m][n]; f32x4 u1 = w1 * cur, u2 = w0 * cur, y = bs + w2 * cur;
                        if (tail) { const int s = grow & 2047;
#pragma unroll
                            for (int j = 0; j < 4; ++j) { u1[j] = s == 2047 ? 0.f : u1[j]; u2[j] = s >= 2046 ? 0.f : u2[j]; } }
                        float z1[4], z2[4], y0 = y[0], y1 = y[1], y2 = y[2], y3 = y[3];
#pragma unroll
                        for (int j = 0; j < 4; ++j) { z1[j] = fr == 15 ? q1[j] : u1[j]; z2[j] = fr >= 14 ? q2[j] : u2[j]; }
                        asm volatile("s_nop 1\n\t"
                                     "v_add_f32_dpp %0, %4, %0 row_ror:1 row_mask:0xf bank_mask:0xf\n\tv_add_f32_dpp %1, %5, %1 row_ror:1 row_mask:0xf bank_mask:0xf\n\t"
                                     "v_add_f32_dpp %2, %6, %2 row_ror:1 row_mask:0xf bank_mask:0xf\n\tv_add_f32_dpp %3, %7, %3 row_ror:1 row_mask:0xf bank_mask:0xf\n\t"
                                     "v_add_f32_dpp %0, %8, %0 row_ror:2 row_mask:0xf bank_mask:0xf\n\tv_add_f32_dpp %1, %9, %1 row_ror:2 row_mask:0xf bank_mask:0xf\n\t"
                                     "v_add_f32_dpp %2, %10, %2 row_ror:2 row_mask:0xf bank_mask:0xf\n\tv_add_f32_dpp %3, %11, %3 row_ror:2 row_mask:0xf bank_mask:0xf"
                                     : "+v"(y0), "+v"(y1), "+v"(y2), "+v"(y3) : "v"(z1[0]), "v"(z1[1]), "v"(z1[2]), "v"(z1[3]), "v"(z2[0]), "v"(z2[1]), "v"(z2[2]), "v"(z2[3]));
                        y = (f32x4){y0, y1, y2, y3};
                        q1 = u1; q2 = u2; __builtin_amdgcn_sched_barrier(0);
                        if (bj == 0) { const f32x2 g0 = gelu_pk((f32x2){y[0], y[1]}), g1 = gelu_pk((f32x2){y[2], y[3]}); gl[m] = (f32x4){g0.x, g0.y, g1.x, g1.y}; }
                        else { const u32x2 o = pack4(gl[m] * y);
                            if (n == 0) held[m] = o;
                            else if (rho >= 2 && grow < 8192) { u32x4 w; w.x = held[m].x; w.y = held[m].y; w.z = o.x; w.w = o.y; ST_BIG((u32x4*)(ACT + (size_t)grow * 5632 + ch), w); } }
                    }
                    __builtin_amdgcn_sched_barrier(0);
                }
            }
        }
    }
};

struct BranchOrder {
    StaticOrder so; int G, c;
    __device__ void init(int G_, int c_) { so.init(8192, 2048, 1, 0); G = G_; c = c_; }
    __device__ bool next(int i, Unit& u) const { const int t = (i >> 1) * G + c; if (t >= 256) return false; Unit v; so.next(t, v); const int br = i & 1; u.pm = v.pm + 32 * br; u.pn = v.pn + 8 * br; return true; }
    __device__ __forceinline__ void a_ready(const Unit&) const {}
    __device__ __forceinline__ void done(const Unit&) const {}
};
template <class Epi, class Sched, bool ALIGN_EPI = false, bool SP2 = false>
__device__ __forceinline__ void gemm_phase(PG8_LAS unsigned char* lds, const Gemm g, const Sched& S, const Epi& E) {
    int tid_o; asm volatile("v_mbcnt_lo_u32_b32 %0, -1, 0\n\tv_mbcnt_hi_u32_b32 %0, -1, %0" : "=v"(tid_o)); tid_o += g.wave_s * 64;
    const int tid = tid_o, wid = __builtin_amdgcn_readfirstlane(tid >> 6), lane = tid & 63, wr = wid >> 2, wc = wid & 3, fr = lane & 15, fq = lane >> 4;
    const int K = g.K, nt = K / BK;
    unsigned voffA[2], voffB[2];
#pragma unroll
    for (int i = 0; i < 2; ++i) { int R, C; stage_rc(tid * 16 + i * 8192, R, C); const int Rb = Epi::PERM ? ((R & ~31) + perm32(R & 31)) : R;
        voffA[i] = (unsigned)(R * K + C) * 2u; voffB[i] = (unsigned)(Rb * K + C) * 2u; }
    const size_t kstep = (size_t)(BK * 2);
    const size_t hstep = (size_t)HALF * K * 2;
    const size_t tstep = 2 * hstep;
    const size_t tstepA = g.a_rows ? (size_t)g.a_rows * K * 2 : tstep;
    const unsigned ldsw = (unsigned)wid * 1024u;
    const int aoff = lds_byte(wr * 64 + fr, fq * 8), boff = lds_byte(wc * 32 + fr, fq * 8);
#define PG8_SA(b, h) (((b) * 2 + (h)) * HTB)
#define PG8_SB(b, h) ((4 + (b) * 2 + (h)) * HTB)
#define PG8_STAGE(bufoff, gbase, voff) do { _Pragma("unroll") for (int _i = 0; _i < 2; ++_i) \
        __builtin_amdgcn_global_load_lds((const unsigned*)((const char*)(gbase) + (voff)[_i]), (PG8_LAS unsigned*)(lds + (bufoff) + ldsw + _i * 8192), 16, 0, 0); } while (0)
#define PG8_LDA(dst, b, h) do { _Pragma("unroll") for (int m = 0; m < 4; ++m) _Pragma("unroll") for (int k = 0; k < 2; ++k) dst[m][k] = *(const PG8_LAS bf16x8*)(lds + PG8_SA(b, h) + aoff + m * 2048 + k * 1024); } while (0)
#define PG8_LDB(dst, b, h) do { _Pragma("unroll") for (int n = 0; n < 2; ++n) _Pragma("unroll") for (int k = 0; k < 2; ++k) dst[n][k] = *(const PG8_LAS bf16x8*)(lds + PG8_SB(b, h) + boff + n * 2048 + k * 1024); } while (0)
#define PG8_MMA(ai, bj, At, Bt) do { __builtin_amdgcn_s_setprio(1); _Pragma("unroll") for (int m = 0; m < 4; ++m) _Pragma("unroll") for (int n = 0; n < 2; ++n) _Pragma("unroll") for (int k = 0; k < 2; ++k) \
        acc[ai][bj][m][n] = __builtin_amdgcn_mfma_f32_16x16x32_bf16(Bt[n][k], At[m][k], acc[ai][bj][m][n], 0, 0, 0); __builtin_amdgcn_s_setprio(0); } while (0)
#define PG8_WAIT_V(n) asm volatile("s_waitcnt vmcnt(" #n ")" ::: "memory")
#define PG8_WAIT_L(n) asm volatile("s_waitcnt lgkmcnt(" #n ")" ::: "memory")
#define PG8_BAR __builtin_amdgcn_s_barrier()
#define PG8_SCHED __builtin_amdgcn_sched_barrier(0)
    Unit cur, nxt; int ui = 0;
    if (!S.next(0, cur)) return;
    f32x4 acc[2][2][4][2];
#pragma unroll
    for (int a = 0; a < 2; ++a)
#pragma unroll
        for (int b = 0; b < 2; ++b)
#pragma unroll
            for (int m = 0; m < 4; ++m)
#pragma unroll
                for (int n = 0; n < 2; ++n) acc[a][b][m][n] = (f32x4){0.f, 0.f, 0.f, 0.f};
    bf16x8 At[4][2], B0[2][2], B1[2][2];
    const char* cA = (const char*)g.A + (size_t)cur.pm * tstepA; const char* cB = (const char*)g.Bt + (size_t)cur.pn * tstep;
    S.a_ready(cur);
    if constexpr (SP2) {
        PG8_STAGE(PG8_SB(0, 0), cB, voffB); PG8_STAGE(PG8_SB(0, 1), cB + hstep, voffB); PG8_STAGE(PG8_SA(0, 0), cA, voffA); PG8_STAGE(PG8_SA(0, 1), cA + hstep, voffA);
        if (wr == 1) PG8_BAR;
        PG8_WAIT_V(2); PG8_BAR;
        PG8_STAGE(PG8_SB(1, 0), cB + kstep, voffB); PG8_STAGE(PG8_SA(1, 0), cA + kstep, voffA); PG8_STAGE(PG8_SB(1, 1), cB + hstep + kstep, voffB);
        PG8_WAIT_V(6); PG8_BAR;
    } else {
        PG8_STAGE(PG8_SB(0, 0), cB, voffB); PG8_STAGE(PG8_SA(0, 0), cA, voffA); PG8_STAGE(PG8_SB(0, 1), cB + hstep, voffB); PG8_STAGE(PG8_SA(0, 1), cA + hstep, voffA);
        if (wr == 1) PG8_BAR;
        PG8_WAIT_V(4); PG8_BAR;
        PG8_STAGE(PG8_SB(1, 0), cB + kstep, voffB); PG8_STAGE(PG8_SA(1, 0), cA + kstep, voffA); PG8_STAGE(PG8_SB(1, 1), cB + hstep + kstep, voffB);
        PG8_WAIT_V(6); PG8_BAR;
    }
    for (;;) {
        const bool has_next = S.next(ui + 1, nxt);
        const char* nA = has_next ? (const char*)g.A + (size_t)nxt.pm * tstepA : cA; const char* nB = has_next ? (const char*)g.Bt + (size_t)nxt.pn * tstep : cB;
        for (int t = 0; t < nt; t += 2) {
            const bool last = (t == nt - 2);
            const char* a1 = cA + (size_t)(t + 1) * kstep;
            const char* a2 = last ? nA : cA + (size_t)(t + 2) * kstep; const char* b2 = last ? nB : cB + (size_t)(t + 2) * kstep;
            const char* a3 = a2 + kstep; const char* b3 = b2 + kstep;
            if (last && has_next) S.a_ready(nxt);
            if constexpr (SP2) {
            PG8_LDB(B0, 0, 0); PG8_LDB(B1, 0, 1); PG8_SCHED; PG8_LDA(At, 0, 0); PG8_STAGE(PG8_SA(1, 1), a1 + hstep, voffA);
            PG8_WAIT_V(8); PG8_WAIT_L(0); PG8_BAR; PG8_MMA(0, 0, At, B0); PG8_MMA(0, 1, At, B1); PG8_BAR; PG8_SCHED;
            PG8_LDA(At, 0, 1); PG8_STAGE(PG8_SB(0, 0), b2, voffB); PG8_STAGE(PG8_SB(0, 1), b2 + hstep, voffB); PG8_STAGE(PG8_SA(0, 0), a2, voffA);
            PG8_WAIT_V(8); PG8_WAIT_L(0); PG8_BAR; PG8_MMA(1, 0, At, B0); PG8_MMA(1, 1, At, B1); PG8_BAR; PG8_SCHED;
            PG8_LDB(B0, 1, 0); PG8_LDB(B1, 1, 1); PG8_SCHED; PG8_LDA(At, 1, 0); PG8_STAGE(PG8_SA(0, 1), a2 + hstep, voffA);
            PG8_WAIT_V(8); PG8_WAIT_L(0); PG8_BAR; PG8_MMA(0, 0, At, B0); PG8_MMA(0, 1, At, B1); PG8_BAR; PG8_SCHED;
            PG8_LDA(At, 1, 1); PG8_STAGE(PG8_SB(1, 0), b3, voffB); PG8_STAGE(PG8_SB(1, 1), b3 + hstep, voffB); PG8_STAGE(PG8_SA(1, 0), a3, voffA);
            PG8_WAIT_V(8); PG8_WAIT_L(0); PG8_BAR; PG8_MMA(1, 0, At, B0); PG8_MMA(1, 1, At, B1); PG8_BAR; PG8_SCHED;
            } else {
            PG8_LDB(B0, 0, 0); PG8_SCHED; PG8_LDA(At, 0, 0); PG8_STAGE(PG8_SA(1, 1), a1 + hstep, voffA);
            PG8_WAIT_L(8); PG8_BAR; PG8_WAIT_L(0); PG8_MMA(0, 0, At, B0); PG8_BAR; PG8_SCHED;
            PG8_LDB(B1, 0, 1); PG8_STAGE(PG8_SB(0, 0), b2, voffB);
            PG8_BAR; PG8_WAIT_L(0); PG8_MMA(0, 1, At, B1); PG8_BAR;
            PG8_LDA(At, 0, 1); PG8_STAGE(PG8_SA(0, 0), a2, voffA);
            PG8_BAR; PG8_WAIT_L(0); PG8_MMA(1, 0, At, B0); PG8_BAR; PG8_SCHED;
            PG8_STAGE(PG8_SB(0, 1), b2 + hstep, voffB);
            PG8_WAIT_V(6); PG8_BAR; PG8_MMA(1, 1, At, B1); PG8_BAR;
            PG8_LDB(B0, 1, 0); PG8_SCHED; PG8_LDA(At, 1, 0); PG8_STAGE(PG8_SA(0, 1), a2 + hstep, voffA);
            PG8_WAIT_L(8); PG8_BAR; PG8_WAIT_L(0); PG8_MMA(0, 0, At, B0); PG8_BAR; PG8_SCHED;
            PG8_LDB(B1, 1, 1); PG8_STAGE(PG8_SB(1, 0), b3, voffB);
            PG8_BAR; PG8_WAIT_L(0); PG8_MMA(0, 1, At, B1); PG8_BAR;
            PG8_LDA(At, 1, 1); PG8_STAGE(PG8_SA(1, 0), a3, voffA);
            PG8_BAR; PG8_WAIT_L(0); PG8_MMA(1, 0, At, B0); PG8_BAR; PG8_SCHED;
            PG8_STAGE(PG8_SB(1, 1), b3 + hstep, voffB);
            PG8_WAIT_V(6); PG8_BAR; PG8_MMA(1, 1, At, B1); PG8_BAR;
            }
        }
        if constexpr (ALIGN_EPI) { if (wr == 0) PG8_BAR; }
        if constexpr (Epi::ROWSCALE) {
            const PG8_LAS float* rp = E.rs + ui * 256 + wr * 64 + fr;
#pragma unroll
            for (int a = 0; a < 2; ++a)
#pragma unroll
                for (int m = 0; m < 4; ++m) { const float r = rp[a * HALF + m * 16];
#pragma unroll
                    for (int b = 0; b < 2; ++b)
#pragma unroll
                        for (int n = 0; n < 2; ++n) acc[a][b][m][n] *= r; }
        }
        if constexpr (!Epi::AFTER_DRAIN) { E(acc, cur, wr, wc, fr, fq); S.done(cur); }
        if (!has_next) break;
#pragma unroll
        for (int a = 0; a < 2; ++a)
#pragma unroll
            for (int b = 0; b < 2; ++b)
#pragma unroll
                for (int m = 0; m < 4; ++m)
#pragma unroll
                    for (int n = 0; n < 2; ++n) acc[a][b][m][n] = (f32x4){0.f, 0.f, 0.f, 0.f};
        cur = nxt; cA = nA; cB = nB; ++ui;
        if constexpr (ALIGN_EPI) { if (wr == 1) PG8_BAR; }
    }
    PG8_WAIT_V(0);
    if constexpr (!ALIGN_EPI) { if (wr == 0) PG8_BAR; }
    PG8_BAR;
    if constexpr (Epi::AFTER_DRAIN) { E.fused(acc, cur, wr, wc, fr, fq, lds, wid, lane); S.done(cur); }
#undef PG8_SA
#undef PG8_SB
#undef PG8_STAGE
#undef PG8_LDA
#undef PG8_LDB
#undef PG8_MMA
#undef PG8_WAIT_V
#undef PG8_WAIT_L
#undef PG8_BAR
#undef PG8_SCHED
}
}

constexpr int D_MODEL = 2048, BATCH = 4, SEQ = 2048, DEPTH = 4, M = BATCH * SEQ;
constexpr size_t ZS = (size_t)M * 1024;
constexpr int CHUNK = 64, NPREV = 8, NBAND = 9, HEADS = 8, HD = 128, AW = 1024, RELCLIP = 256, NREL = 2 * RELCLIP + 1;
constexpr int D_FF = 5632, D_IN = 11264;
constexpr int ZP = 1024;
constexpr float EPS = 1e-6f;
typedef unsigned short bf16;
typedef float f32x4 __attribute__((ext_vector_type(4)));
typedef unsigned v4u __attribute__((ext_vector_type(4)));
typedef unsigned v2u __attribute__((ext_vector_type(2)));
#define LAS __attribute__((address_space(3)))
#define GAS __attribute__((address_space(1)))
typedef GAS unsigned gu32;
#define RLX_AGENT __ATOMIC_RELAXED, __HIP_MEMORY_SCOPE_AGENT
#define LDS_WAIT() asm volatile("s_waitcnt lgkmcnt(0)" ::: "memory")
#define VM_WAIT() asm volatile("s_waitcnt vmcnt(0)" ::: "memory")
constexpr int NWAVES = 8;

__device__ __forceinline__ unsigned f2bf(float f) { unsigned u = __builtin_bit_cast(unsigned, f); return (u + 0x7fffu + ((u >> 16) & 1u)) >> 16; }
__device__ __forceinline__ unsigned pk2(float lo, float hi) { return f2bf(lo) | (f2bf(hi) << 16); }
__device__ __forceinline__ float bf2f(bf16 b) { return __uint_as_float(((unsigned)b) << 16); }
__device__ __forceinline__ float lg2_gamma(int h) { const float e = __builtin_ldexpf(1.0f, -5 - h);
    return -1.4426950408889634f * e * (1.0f + e * (0.5f + e * (0.3333333333f + e * (0.25f + e * (0.2f + e * 0.1666666667f))))); }
#define DPP_ROR(v, n) __uint_as_float(__builtin_amdgcn_update_dpp(0u, __float_as_uint(v), 0x120 + (n), 0xf, 0xf, true))
__device__ __forceinline__ float swap16_sum(float v) { auto rr = __builtin_amdgcn_permlane16_swap(__float_as_uint(v), __float_as_uint(v), false, false); return __uint_as_float(rr[0]) + __uint_as_float(rr[1]); }
__device__ __forceinline__ float swap32_sum(float v) { auto rr = __builtin_amdgcn_permlane32_swap(__float_as_uint(v), __float_as_uint(v), false, false); return __uint_as_float(rr[0]) + __uint_as_float(rr[1]); }
__device__ __forceinline__ float swap16_max(float v) { auto rr = __builtin_amdgcn_permlane16_swap(__float_as_uint(v), __float_as_uint(v), false, false); return fmaxf(__uint_as_float(rr[0]), __uint_as_float(rr[1])); }
__device__ __forceinline__ float swap32_max(float v) { auto rr = __builtin_amdgcn_permlane32_swap(__float_as_uint(v), __float_as_uint(v), false, false); return fmaxf(__uint_as_float(rr[0]), __uint_as_float(rr[1])); }
__device__ __forceinline__ float wave_sum(float v) {
    v += DPP_ROR(v, 8); v += DPP_ROR(v, 4); v += DPP_ROR(v, 2); v += DPP_ROR(v, 1);
    return swap32_sum(swap16_sum(v));
}
__device__ __forceinline__ float wave_max(float v) {
    v = fmaxf(v, DPP_ROR(v, 8)); v = fmaxf(v, DPP_ROR(v, 4)); v = fmaxf(v, DPP_ROR(v, 2)); v = fmaxf(v, DPP_ROR(v, 1));
    return swap32_max(swap16_max(v));
}

#define GIN(k) ((const float*)(GAS const float*)args.in[k])
__device__ __forceinline__ int tid_now(int wave_s) { int l; asm volatile("v_mbcnt_lo_u32_b32 %0, -1, 0\n\tv_mbcnt_hi_u32_b32 %0, -1, %0" : "=v"(l)); return wave_s * 64 + l; }
template <class T> __device__ __forceinline__ T* opq_global(T* p) { GAS T* g = (GAS T*)p; asm volatile("" : "+s"(g)); return (T*)g; }
constexpr int NPH = 6;
enum { PH_GEMM1 = 0, PH_MIX, PH_BR, PH_WO, PH_UP, PH_DOWN };
constexpr int N_PHASES = 1 + DEPTH * NPH;
#ifndef PROBE_PH
#define PROBE_PH (-1)
#endif
#ifndef PROBE_N
#define PROBE_N 2
#endif
#ifndef ONE_LAUNCH
#define ONE_LAUNCH 1
#endif

constexpr size_t MiB = 1u << 20;
constexpr size_t WS_CTL = 0, CTL_ZERO_BYTES = 1 * MiB;
constexpr size_t WS_WIN = 1 * MiB, WS_WBR = WS_WIN + 176 * MiB, WS_WO = WS_WBR + 32 * MiB, WS_WUP = WS_WO + 32 * MiB, WS_WDN = WS_WUP + 176 * MiB;
constexpr size_t WS_CS = WS_WDN + 88 * MiB;
constexpr size_t WS_X = WS_CS + 1 * MiB, WS_H0 = WS_X + 64 * MiB, WS_H = WS_H0 + 1 * MiB, WS_ZB = WS_H0 + 34 * MiB;
constexpr size_t WS_KV = WS_ZB + 176 * MiB, WS_RP = WS_KV + 64 * MiB, WS_SSQ = WS_KV + 32 * MiB;
constexpr size_t WS_YAR = WS_RP + 32 * MiB, WS_MRG = WS_YAR + 32 * MiB, WS_ACT = WS_MRG + 32 * MiB, WS_END = WS_ACT + 88 * MiB;
constexpr int CW_TMO = 64, CW_FLAG = 16384;
constexpr int CW_CQ = 8192;
constexpr int CW_BAR = 4096;

constexpr int RING_OFF = 0, RING_BYTES = 131072, XCH_OFF = RING_BYTES, XCH_BYTES = 8192;
constexpr int TAB_OFF = 153600;
constexpr int LDS_BYTES = 163840, MISC_OFF = LDS_BYTES - 256, RS_OFF = XCH_OFF + 12288;

struct Args { const float* in[14]; float* out; unsigned char* ws; int ph_lo, ph_hi; };

#ifndef PROBE_WRITES
#define PROBE_WRITES 0
#endif
struct ConvItem { const float* W; bf16* WT; const float* g; int K, N, r, mode; };
constexpr int I_IN = (D_MODEL / 64) * (D_IN / 64), I_BR = 2 * (AW / 64) * (D_MODEL / 64), I_O = (D_MODEL / 64) * (D_MODEL / 64), I_UP = I_IN, I_DN = (D_FF / 64) * (D_MODEL / 64);
constexpr int I_L = I_IN + I_BR + I_O + I_UP + I_DN;
#ifndef TAIL_PCT
#define TAIL_PCT 100
#endif
#ifndef TAIL1_PCT
#define TAIL1_PCT 60
#endif
constexpr int I_PRO = I_L - (I_L / 100) * TAIL_PCT, I_SPLIT = I_PRO + ((I_L - I_PRO) / 100) * TAIL1_PCT;
__device__ __forceinline__ ConvItem conv_item(const Args& args, unsigned char* ws, int git) {
    const int l = git / I_L; int r = git % I_L; ConvItem c; c.K = D_MODEL; c.N = D_IN; c.mode = 0; c.g = nullptr;
    if (r < I_IN) { c.W = GIN(1) + (size_t)l * D_MODEL * D_IN; c.WT = (bf16*)(ws + WS_WIN) + (size_t)l * D_IN * D_MODEL; c.mode = 1; c.g = GIN(4) + (size_t)l * D_MODEL; }
    else if ((r -= I_IN) < I_BR) { const int br = r / (I_BR / 2); r -= br * (I_BR / 2); c.K = AW; c.N = D_MODEL; c.W = GIN(2) + (size_t)(2 * l + br) * AW * D_MODEL; c.WT = (bf16*)(ws + WS_WBR) + (size_t)(2 * l + br) * D_MODEL * AW; }
    else if ((r -= I_BR) < I_O) { c.N = D_MODEL; c.W = GIN(3) + (size_t)l * D_MODEL * D_MODEL; c.WT = (bf16*)(ws + WS_WO) + (size_t)l * D_MODEL * D_MODEL; }
    else if ((r -= I_O) < I_UP) { c.W = GIN(10) + (size_t)l * D_MODEL * D_IN; c.WT = (bf16*)(ws + WS_WUP) + (size_t)l * D_IN * D_MODEL; c.mode = 2; c.g = GIN(9) + (size_t)l * D_MODEL; }
    else { r -= I_UP; c.K = D_FF; c.N = D_MODEL; c.W = GIN(13) + (size_t)l * D_FF * D_MODEL; c.WT = (bf16*)(ws + WS_WDN) + (size_t)l * D_MODEL * D_FF; }
    c.r = r; return c;
}
__device__ __forceinline__ void conv_load(const ConvItem& c, const float* gdef, f32x4 (&v)[16], f32x4 (&gk)[2], int lane) {
    const int nblk = c.N / 64, k0 = 64 * (c.r / nblk), n0 = 64 * (c.r % nblk); const float* p = c.W + (size_t)(k0 + (lane >> 4)) * c.N + n0 + 4 * (lane & 15);
#pragma unroll
    for (int j = 0; j < 16; ++j) v[j] = __builtin_nontemporal_load((const f32x4*)(p + (size_t)(4 * j) * c.N));
    const float* gp = (c.g ? c.g : gdef) + (c.g ? k0 : 0) + 8 * (lane & 7);
    gk[0] = *(const f32x4*)gp; gk[1] = *(const f32x4*)(gp + 4);
}
__device__ __forceinline__ void conv_store(const ConvItem& cc, const f32x4 (&v)[16], const f32x4 (&gk)[2], LAS float* scr, int lane) {
    const int nblk = cc.N / 64, k0 = 64 * (cc.r / nblk), n0 = 64 * (cc.r % nblk), K = cc.K, mode = cc.mode;
    { LAS float* d = scr + (lane >> 4) * 65 + 4 * (lane & 15);
#pragma unroll
      for (int j = 0; j < 16; ++j) { d[4 * j * 65] = v[j].x; d[4 * j * 65 + 1] = v[j].y; d[4 * j * 65 + 2] = v[j].z; d[4 * j * 65 + 3] = v[j].w; } }
    LDS_WAIT(); asm volatile("" ::: "memory");
    const int c = lane & 7; const bool has = cc.g != nullptr; const f32x4 one4 = (f32x4){1.f, 1.f, 1.f, 1.f}; const f32x4 g0 = has ? gk[0] : one4, g1 = has ? gk[1] : one4;
#pragma unroll
    for (int j = 0; j < 8; ++j) { const int n = (lane >> 3) + 8 * j; const LAS float* s = scr + (8 * c) * 65 + n;
        v4u o; o.x = pk2(s[0 * 65] * g0.x, s[1 * 65] * g0.y); o.y = pk2(s[2 * 65] * g0.z, s[3 * 65] * g0.w); o.z = pk2(s[4 * 65] * g1.x, s[5 * 65] * g1.y); o.w = pk2(s[6 * 65] * g1.z, s[7 * 65] * g1.w);
        const int col = n0 + n; int drow = col;
        if (mode == 2) { const int half = col >= D_FF, ch = half ? col - D_FF : col; drow = 256 * (ch >> 7) + 128 * half + (ch & 127); }
        if (mode == 1) { const int sec = col >> 10; if (sec == 3 || sec == 4) { const int hd = (col >> 7) & 1, d = col & 127; drow = (col & ~255) + 128 * (d >> 6) + 64 * hd + (d & 63); } }
        *(v4u*)(cc.WT + (size_t)drow * K + k0 + 8 * c) = o; }
    LDS_WAIT(); asm volatile("" ::: "memory");
}
__device__ __forceinline__ void convert_all(const Args& args, unsigned char* ws, int first, int nitems, int wi, int nw, LAS float* scr, int lane) {
    f32x4 va[16], vb[16], ga[2], gb[2]; int it = first + wi;
    if (it >= nitems) return;
    const float* gdef = GIN(4); const int last = it + ((nitems - 1 - it) / nw) * nw;
    ConvItem ca = conv_item(args, ws, it), cb; conv_load(ca, gdef, va, ga, lane);
    for (;;) {
        { const int nx = it + nw; cb = conv_item(args, ws, nx <= last ? nx : last); conv_load(cb, gdef, vb, gb, lane); }
        conv_store(ca, va, ga, scr, lane); if (it + nw > last) break; it += nw;
        { const int nx = it + nw; ca = conv_item(args, ws, nx <= last ? nx : last); conv_load(ca, gdef, va, ga, lane); }
        conv_store(cb, vb, gb, scr, lane); if (it + nw > last) break; it += nw;
    }
}
#ifndef REP_G1
#define REP_G1 1
#endif
#ifndef REP_UP
#define REP_UP 1
#endif
#ifndef SPLIT_G1
#define SPLIT_G1 73
#endif
#ifndef SPLIT_UP
#define SPLIT_UP 70
#endif
#ifndef CONV_QUEUE
#define CONV_QUEUE 0
#endif
#ifndef CONV_FIRST
#define CONV_FIRST 1
#endif
#ifndef CONV_IN_TAILS
#define CONV_IN_TAILS 1
#endif
typedef short bf16x8 __attribute__((ext_vector_type(8)));
typedef short s16x4 __attribute__((ext_vector_type(4)));
typedef float f32x16 __attribute__((ext_vector_type(16)));
__device__ __forceinline__ int crow(int r, int hh) { return (r & 3) + 8 * (r >> 2) + 4 * hh; }
__device__ __forceinline__ s16x4 tr_read(LAS const unsigned char* p) { return __builtin_bit_cast(s16x4, __builtin_amdgcn_ds_read_tr16_b64_v4i16((LAS s16x4*)p)); }
__device__ __forceinline__ bf16x8 cat8(s16x4 a, s16x4 b) { return (bf16x8){a[0], a[1], a[2], a[3], b[0], b[1], b[2], b[3]}; }
__device__ __forceinline__ float swap_max(float v) { auto rr = __builtin_amdgcn_permlane32_swap(__float_as_uint(v), __float_as_uint(v), false, false); return fmaxf(__uint_as_float(rr[0]), __uint_as_float(rr[1])); }
__device__ __forceinline__ float swap_sum(float v) { auto rr = __builtin_amdgcn_permlane32_swap(__float_as_uint(v), __float_as_uint(v), false, false); return __uint_as_float(rr[0]) + __uint_as_float(rr[1]); }
__device__ __forceinline__ bf16x8 pack_frag(const f32x16& p, int s) {
    pg8::u32x4 w; w.x = pg8::cvt_pk_bf16(p[8 * s + 0], p[8 * s + 1]); w.y = pg8::cvt_pk_bf16(p[8 * s + 2], p[8 * s + 3]); w.z = pg8::cvt_pk_bf16(p[8 * s + 4], p[8 * s + 5]); w.w = pg8::cvt_pk_bf16(p[8 * s + 6], p[8 * s + 7]);
    return __builtin_bit_cast(bf16x8, w);
}
template <class T> __device__ __forceinline__ T gld(const void* base, unsigned off, int imm = 0) { return *(const T*)((const char*)base + (size_t)off + imm); }
template <class T> __device__ __forceinline__ void gst(void* base, unsigned off, int imm, T v) { *(T*)((char*)base + (size_t)off + imm) = v; }
struct MixAddr { unsigned dk, dv; };
__device__ __forceinline__ void mix_addr(MixAddr& A, int lane) {
    A.dk = (unsigned)(lane & 31) * (ZP * 2) + 16u * (unsigned)(lane >> 5);
    const int l5 = lane & 31; A.dv = (unsigned)(4 * (l5 >> 4) + ((lane & 7) >> 1)) * (ZP * 2) + 64u * (unsigned)(lane >> 5) + 32u * (unsigned)((l5 >> 3) & 1) + 16u * (unsigned)(lane & 1);
}
__device__ __forceinline__ void dma_k(const bf16* g, LAS unsigned char* img, const MixAddr& A, int wave) {
#pragma unroll
    for (int w = 0; w < 2; ++w) { const int P = 2 * wave + w; __builtin_amdgcn_global_load_lds((const unsigned*)((const char*)g + (size_t)(32 * (P >> 3)) * (ZP * 2) + 32 * (P & 7) + A.dk), (LAS unsigned*)(img + P * 1024), 16, 0, 0); }
}
__device__ __forceinline__ void dma_v(const bf16* g, LAS unsigned char* img, const MixAddr& A, int wave) {
#pragma unroll
    for (int w = 0; w < 2; ++w) { const int P = 2 * wave + w; __builtin_amdgcn_global_load_lds((const unsigned*)((const char*)g + (size_t)(8 * (P >> 1)) * (ZP * 2) + 128 * (P & 1) + A.dv), (LAS unsigned*)(img + P * 1024), 16, 0, 0); }
}
__device__ __forceinline__ bf16x8 kfrag(LAS const unsigned char* img, int lane, int kb, int ks) { return *(LAS const bf16x8*)(img + (8 * kb + ks) * 1024 + 16 * lane); }
__device__ __forceinline__ bf16x8 vfrag(LAS const unsigned char* img, int lane, int rb, int db) { return cat8(tr_read(img + ((rb >> 3) * 4 + db) * 512 + 8 * lane), tr_read(img + ((rb >> 3) * 4 + 4 + db) * 512 + 8 * lane)); }
#define MIX_WAIT_BAR(N) asm volatile("s_waitcnt vmcnt(" #N ")\n\ts_barrier" ::: "memory")

__device__ __forceinline__ void state_phase(LAS unsigned char* lds, unsigned char* ws, unsigned epoch, int bx, int G, int tid) {
    const int lane = tid & 63, wave = __builtin_amdgcn_readfirstlane(tid >> 6), hh = lane >> 5, l31 = lane & 31;
    constexpr int STG = 32768;
    const bf16* ZB = (const bf16*)(ws + WS_ZB);
    MixAddr A; mix_addr(A, lane);
    for (int u = bx; u < BATCH * HEADS * 8; u += G) {
        const int gq = (u & 7) * 4 + (u >> 6), qb = (u >> 3) & 7, h = gq & 7, b = gq >> 3;
        const bf16* kvbase = ZB + (size_t)b * SEQ * ZP + h * HD;
        {
            unsigned char* wsl = opq_global(ws);
            float* GS = (float*)(wsl + WS_KV); gu32* flags = (gu32*)(wsl + WS_CTL) + CW_FLAG; gu32* tmo = (gu32*)(wsl + WS_CTL) + CW_TMO; bf16* RP = (bf16*)(wsl + WS_RP);
            const float lg = lg2_gamma(h); const float g1 = __builtin_amdgcn_exp2f(lg), g63 = __builtin_amdgcn_exp2f(63.0f * lg), g64 = __builtin_amdgcn_exp2f(64.0f * lg), g256 = __builtin_amdgcn_exp2f(256.0f * lg);
#pragma unroll
            for (int ci = 0; ci < 4; ++ci) { const bf16* tp = kvbase + (size_t)((4 * qb + ci) * CHUNK) * ZP; dma_v(tp + 4 * ZS, lds + ci * STG, A, wave); dma_v(tp + 5 * ZS, lds + ci * STG + 16384, A, wave); }
            MIX_WAIT_BAR(0);
            f32x16 L[2]; unsigned Lp[3][2][8];
#pragma unroll
            for (int q = 0; q < 2; ++q)
#pragma unroll
                for (int r = 0; r < 16; ++r) L[q][r] = 0.f;
#pragma unroll
            for (int ci = 0; ci < 4; ++ci) { LAS const unsigned char* KI = lds + ci * STG; LAS const unsigned char* VI = KI + 16384;
#pragma unroll
                for (int q = 0; q < 2; ++q) { const int id = 2 * wave + q, eb = id >> 2, db = id & 3; f32x16 kv;
#pragma unroll
                    for (int r = 0; r < 16; ++r) kv[r] = 0.f;
                    bf16x8 af[4], bfr[4];
#pragma unroll
                    for (int ks = 0; ks < 4; ++ks) { af[ks] = vfrag(VI, lane, 16 * ks, eb); bfr[ks] = vfrag(KI, lane, 16 * ks, db); }
                    __builtin_amdgcn_sched_barrier(0);
#pragma unroll
                    for (int ks = 0; ks < 4; ++ks) kv = __builtin_amdgcn_mfma_f32_32x32x16_bf16(af[ks], bfr[ks], kv, 0, 0, 0);
#pragma unroll
                    for (int r = 0; r < 16; ++r) L[q][r] = L[q][r] * g64 + kv[r] * g63; }
                if (ci < 3) {
#pragma unroll
                    for (int q = 0; q < 2; ++q)
#pragma unroll
                        for (int r = 0; r < 8; ++r) Lp[ci][q][r] = pg8::cvt_pk_bf16(L[q][2 * r], L[q][2 * r + 1]); } }
            const unsigned go = (unsigned)(4 * hh * HD + l31) * 4u;
#pragma unroll
            for (int q = 0; q < 2; ++q) { const int id = 2 * wave + q, eb = id >> 2, db = id & 3; float* gs = GS + (size_t)u * (HD * HD) + 32 * eb * HD + 32 * db;
#pragma unroll
                for (int r = 0; r < 16; ++r) __hip_atomic_store((gu32*)((char*)(gs + 8 * (r >> 2) * HD) + (size_t)go + (r & 3) * HD * 4), __float_as_uint(L[q][r]), RLX_AGENT); }
            asm volatile("s_waitcnt vmcnt(0)" ::: "memory"); __syncthreads();
            if (tid == 0) __hip_atomic_store(flags + 64 * u, epoch, RLX_AGENT);
            if (tid < qb) { gu32* f = flags + 64 * (u - 8 * (qb - tid)); unsigned sp = 0;
                while (__hip_atomic_load(f, RLX_AGENT) != epoch) { __builtin_amdgcn_s_sleep(1);
                    if ((++sp & 255u) == 0u) { if (__hip_atomic_load(tmo, RLX_AGENT)) break; if (sp > (1u << 18)) { __hip_atomic_store(tmo, 1u, RLX_AGENT); break; } } } }
            __builtin_amdgcn_fence(__ATOMIC_ACQUIRE, "agent"); asm volatile("s_waitcnt vmcnt(0)" ::: "memory"); __syncthreads();
            f32x16 S[2];
#pragma unroll
            for (int q = 0; q < 2; ++q)
#pragma unroll
                for (int r = 0; r < 16; ++r) S[q][r] = 0.f;
            { float wgt = 1.0f;
#pragma unroll 1
              for (int gp = qb - 1; gp >= 0; gp -= 2) { const bool two = gp >= 1; const int gp2 = two ? gp - 1 : gp; float t0[2][16], t1[2][16];
#pragma unroll
                  for (int q = 0; q < 2; ++q) { const int id = 2 * wave + q, eb = id >> 2, db = id & 3;
                      const float* gg = GS + (size_t)(u - 8 * (qb - gp)) * (HD * HD) + 32 * eb * HD + 32 * db; const float* gh = GS + (size_t)(u - 8 * (qb - gp2)) * (HD * HD) + 32 * eb * HD + 32 * db;
#pragma unroll
                      for (int r = 0; r < 16; ++r) { t0[q][r] = gld<float>(gg + 8 * (r >> 2) * HD, go, (r & 3) * HD * 4); t1[q][r] = gld<float>(gh + 8 * (r >> 2) * HD, go, (r & 3) * HD * 4); } }
                  __builtin_amdgcn_sched_barrier(0);
                  const float w1 = two ? wgt * g256 : 0.f;
#pragma unroll
                  for (int q = 0; q < 2; ++q)
#pragma unroll
                      for (int r = 0; r < 16; ++r) S[q][r] += wgt * t0[q][r] + w1 * t1[q][r];
                  wgt *= g256 * g256; } }
            bf16* rpo = RP + ((size_t)((b * HEADS + h) * 32 + 4 * qb)) * (HD * HD);
#pragma unroll
            for (int half = 0; half < 2; ++half) {
#pragma unroll
                for (int j = 0; j < 2; ++j) { const int i = 2 * half + j;
#pragma unroll
                    for (int q = 0; q < 2; ++q) { const int id = 2 * wave + q, eb = id >> 2, db = id & 3; LAS float* img = (LAS float*)(lds + j * 65536);
#pragma unroll
                        for (int r = 0; r < 16; ++r) { const float li = i == 0 ? 0.f : ((r & 1) ? __uint_as_float(Lp[i ? i - 1 : 0][q][r >> 1] & 0xffff0000u) : __uint_as_float(Lp[i ? i - 1 : 0][q][r >> 1] << 16)); const float sc = i == 0 ? 1.0f : (i == 1 ? g64 : (i == 2 ? g64 * g64 : g64 * g64 * g64));
                            img[(32 * eb + crow(r, hh)) * HD + 32 * db + l31] = g1 * (sc * S[q][r] + li); } } }
                asm volatile("s_waitcnt lgkmcnt(0)\n\ts_barrier" ::: "memory");
#pragma unroll
                for (int k = 0; k < 8; ++k) {
                    const f32x4 a = *(LAS const f32x4*)(lds + tid * 32 + k * 16384), c = *(LAS const f32x4*)(lds + tid * 32 + k * 16384 + 16);
                    gst<pg8::u32x4>(rpo + (size_t)half * 2 * (HD * HD) + k * 4096, (unsigned)tid * 16u, 0, pg8::pack8(a, c)); }
                asm volatile("s_waitcnt lgkmcnt(0)\n\ts_barrier" ::: "memory");
            }
            asm volatile("s_waitcnt vmcnt(0)" ::: "memory"); __syncthreads();
        }
        __syncthreads();
    }
}
__device__ __forceinline__ void mix_phase(LAS unsigned char* lds, unsigned char* ws, unsigned epoch, const float* rel_bias, const float* rgain, int bx, int G, int tid) {
    const bf16* ZB = (const bf16*)(ws + WS_ZB);
    const int lane = tid & 63, wave = __builtin_amdgcn_readfirstlane(tid >> 6), hh = lane >> 5, l31 = lane & 31;
    constexpr int STG = 32768, BIAS_OFF = 4 * STG;
    LAS float* bias_s = (LAS float*)(lds + BIAS_OFF);
    MixAddr A; mix_addr(A, lane);
    for (int u = bx; u < BATCH * HEADS * 8; u += G) {
        const int gq = (u & 7) * 4 + (u >> 6), qb = (u >> 3) & 7, h = gq & 7, b = gq >> 3;
        const int cq = 4 * qb + (wave >> 1), nloc = 32 * (wave & 1) + l31;
        const bf16* zq = ZB + ((size_t)b * SEQ + cq * CHUNK) * ZP + h * HD;
        const unsigned zo = (unsigned)nloc * (ZP * 2) + 16 * hh;
        const bf16* kvbase = ZB + (size_t)b * SEQ * ZP + h * HD;
        bf16x8 qf[8]; f32x16 O[4];
        {
        for (int i = tid; i < NREL; i += 512) bias_s[i] = rel_bias[h * NREL + i] * 1.4426950408889634f;
#pragma unroll
        for (int ks = 0; ks < 8; ++ks) qf[ks] = gld<bf16x8>(zq, zo, 32 * ks);
#pragma unroll
        for (int db = 0; db < 4; ++db)
#pragma unroll
            for (int r = 0; r < 16; ++r) O[db][r] = 0.f;
        float m_run = -INFINITY, l_run = 0.f;
        const int t0 = (8 - 4 * qb) > 0 ? (8 - 4 * qb) : 0;
#pragma unroll
        for (int d = 0; d < 2; ++d) if (t0 + d < 12) { const bf16* tp = kvbase + (size_t)((4 * qb - 8 + t0 + d) * CHUNK) * ZP; dma_k(tp + ZS, lds + d * STG, A, wave); dma_v(tp + 2 * ZS, lds + d * STG + 16384, A, wave); }
#define PEND_PV() do { LAS const unsigned char* VP = lds + pend_st * STG + 16384; bf16x8 va_[8], vb_[8]; \
            _Pragma("unroll") for (int i = 0; i < 8; ++i) { va_[i] = vfrag(VP, lane, 16 * (i >> 2), i & 3); vb_[i] = vfrag(VP, lane, 32 + 16 * (i >> 2), i & 3); } \
            __builtin_amdgcn_sched_barrier(0); \
            _Pragma("unroll") for (int g = 0; g < 2; ++g) _Pragma("unroll") for (int db = 0; db < 4; ++db) O[db] = __builtin_amdgcn_mfma_f32_32x32x16_bf16(va_[4 * g + db], pfp[g], O[db], 0, 0, 0); \
            _Pragma("unroll") for (int g = 0; g < 2; ++g) _Pragma("unroll") for (int db = 0; db < 4; ++db) O[db] = __builtin_amdgcn_mfma_f32_32x32x16_bf16(vb_[4 * g + db], pfp[2 + g], O[db], 0, 0, 0); \
            pend_st = -1; } while (0)
        auto band_loop = [&](auto skc) __attribute__((always_inline)) { constexpr bool skew = decltype(skc)::value;
        bf16x8 pfp[4]; int pend_st = -1;
#pragma unroll
        for (int i = 0; i < 4; ++i) pfp[i] = (bf16x8){0, 0, 0, 0, 0, 0, 0, 0};
        int st = 0;
        for (int t = t0; t < 12; ++t) {
            const int kc = 4 * qb - 8 + t;
            if (t + 1 < 12) MIX_WAIT_BAR(4); else MIX_WAIT_BAR(0);
            if (t + 2 < 12) { const int s2 = (st + 2) & 3; const bf16* tp = kvbase + (size_t)((kc + 2) * CHUNK) * ZP;
                dma_k(tp + ZS, lds + s2 * STG, A, wave); dma_v(tp + 2 * ZS, lds + s2 * STG + 16384, A, wave); }
            if constexpr (skew) { if (pend_st >= 0) PEND_PV(); }
            if (kc >= cq - NPREV && kc <= cq) {
                LAS const unsigned char* KT = lds + st * STG; LAS const unsigned char* VT = KT + 16384;
                f32x16 s[2];
#pragma unroll
                for (int kb = 0; kb < 2; ++kb) { bf16x8 kf[8];
#pragma unroll
                    for (int i = 0; i < 8; ++i) kf[i] = kfrag(KT, lane, kb, i);
#pragma unroll
                    for (int r = 0; r < 16; ++r) s[kb][r] = 0.f;
                    __builtin_amdgcn_sched_barrier(0);
#pragma unroll
                    for (int ks = 0; ks < 8; ++ks) s[kb] = __builtin_amdgcn_mfma_f32_32x32x16_bf16(kf[ks], qf[ks], s[kb], 0, 0, 0);
                    __builtin_amdgcn_sched_barrier(0); }
                __builtin_amdgcn_sched_barrier(0);
                bf16x8 vfa[8];
                if constexpr (!skew) {
#pragma unroll
                    for (int i = 0; i < 8; ++i) vfa[i] = vfrag(VT, lane, 16 * (i >> 2), i & 3); }
                float mx = -INFINITY;
                if (cq - kc >= 5) { const float bc = bias_s[2 * RELCLIP];
#pragma unroll
                    for (int kb = 0; kb < 2; ++kb)
#pragma unroll
                        for (int r = 0; r < 16; ++r) { s[kb][r] += bc; mx = fmaxf(mx, s[kb][r]); }
                } else { const int dbase = (cq - kc) * CHUNK + nloc + RELCLIP - 4 * hh;
#pragma unroll
                    for (int kb = 0; kb < 2; ++kb) { float bv[16];
#pragma unroll
                        for (int r = 0; r < 16; ++r) { int idx = dbase - (32 * kb + (r & 3) + 8 * (r >> 2)); idx = idx > 2 * RELCLIP ? 2 * RELCLIP : idx; bv[r] = bias_s[idx]; }
                        __builtin_amdgcn_sched_barrier(0);
#pragma unroll
                        for (int r = 0; r < 16; ++r) { s[kb][r] += bv[r]; mx = fmaxf(mx, s[kb][r]); }
                        __builtin_amdgcn_sched_barrier(0); } }
                mx = swap_max(mx);
                const float m_new = fmaxf(m_run, mx), alpha = __builtin_amdgcn_exp2f(m_run - m_new); m_run = m_new;
                float ps = 0.f;
#pragma unroll
                for (int kb = 0; kb < 2; ++kb)
#pragma unroll
                    for (int r = 0; r < 16; ++r) { s[kb][r] = __builtin_amdgcn_exp2f(s[kb][r] - m_new); ps += s[kb][r]; }
                l_run = l_run * alpha + ps;
                if (__builtin_amdgcn_ballot_w64(alpha != 1.0f) != 0ull) {
#pragma unroll
                    for (int db = 0; db < 4; ++db)
#pragma unroll
                        for (int r = 0; r < 16; ++r) O[db][r] *= alpha; }
                __builtin_amdgcn_sched_barrier(0);
                if constexpr (!skew) {
                bf16x8 vfb[8];
#pragma unroll
                for (int i = 0; i < 8; ++i) vfb[i] = vfrag(VT, lane, 32 + 16 * (i >> 2), i & 3);
                __builtin_amdgcn_sched_barrier(0);
#pragma unroll
                for (int g = 0; g < 2; ++g) { const bf16x8 pf = pack_frag(s[0], g);
#pragma unroll
                    for (int db = 0; db < 4; ++db) O[db] = __builtin_amdgcn_mfma_f32_32x32x16_bf16(vfa[4 * g + db], pf, O[db], 0, 0, 0); }
#pragma unroll
                for (int g = 0; g < 2; ++g) { const bf16x8 pf = pack_frag(s[1], g);
#pragma unroll
                    for (int db = 0; db < 4; ++db) O[db] = __builtin_amdgcn_mfma_f32_32x32x16_bf16(vfb[4 * g + db], pf, O[db], 0, 0, 0); }
                } else { pfp[0] = pack_frag(s[0], 0); pfp[1] = pack_frag(s[0], 1); pfp[2] = pack_frag(s[1], 0); pfp[3] = pack_frag(s[1], 1); pend_st = st; }
            }
            st = (st + 1) & 3;
        }
        if constexpr (skew) { if (pend_st >= 0) PEND_PV(); }
        };
        if (wave >= 4) band_loop(std::integral_constant<bool, true>{}); else band_loop(std::integral_constant<bool, false>{});
#undef PEND_PV
        { unsigned char* wsl = opq_global(ws); bf16* YAR = (bf16*)(wsl + WS_YAR);
          const float rl = 1.0f / swap_sum(l_run); bf16* yq = YAR + ((size_t)b * SEQ + cq * CHUNK) * AW + h * HD; const unsigned yo = (unsigned)nloc * (AW * 2) + 8 * hh;
#pragma unroll
            for (int db = 0; db < 4; ++db)
#pragma unroll
                for (int rg = 0; rg < 4; ++rg) { v2u w; w.x = pg8::cvt_pk_bf16(O[db][4 * rg] * rl, O[db][4 * rg + 1] * rl); w.y = pg8::cvt_pk_bf16(O[db][4 * rg + 2] * rl, O[db][4 * rg + 3] * rl);
                    gst<v2u>(yq, yo, 64 * db + 16 * rg, w); } }
        asm volatile("s_waitcnt lgkmcnt(0)\n\ts_barrier" ::: "memory");
        }
        {
        const bf16* kvb = opq_global(kvbase);
#pragma unroll
        for (int ci = 0; ci < 4; ++ci) { const bf16* tp = kvb + (size_t)((4 * qb + ci) * CHUNK) * ZP; dma_k(tp + 4 * ZS, lds + ci * STG, A, wave); dma_v(tp + 5 * ZS, lds + ci * STG + 16384, A, wave); }
#pragma unroll
        for (int ks = 0; ks < 8; ++ks) qf[ks] = gld<bf16x8>(zq + 3 * ZS, zo, 32 * ks);
        unsigned char* wsb = opq_global(ws); const bf16* RP = (const bf16*)(wsb + WS_RP); bf16* YAR = (bf16*)(wsb + WS_YAR);
        const bf16* rq = RP + ((size_t)((b * HEADS + h) * 32 + cq)) * (HD * HD); const unsigned ro = (unsigned)l31 * (HD * 2) + 16 * hh;
        bf16x8 rf[16];
#pragma unroll
        for (int i = 0; i < 16; ++i) rf[i] = gld<bf16x8>(rq + 32 * (i >> 3) * HD, ro, 32 * (i & 7));
        __builtin_amdgcn_sched_barrier(0);
        MIX_WAIT_BAR(0);
        {
            LAS const unsigned char* KT = lds + (wave >> 1) * STG; LAS const unsigned char* VT = KT + 16384;
#pragma unroll
            for (int eb = 0; eb < 4; ++eb)
#pragma unroll
                for (int r = 0; r < 16; ++r) O[eb][r] = 0.f;
#pragma unroll
            for (int i = 0; i < 16; ++i) O[i >> 3] = __builtin_amdgcn_mfma_f32_32x32x16_bf16(rf[i], qf[i & 7], O[i >> 3], 0, 0, 0);
            __builtin_amdgcn_sched_barrier(0);
#pragma unroll
            for (int i = 0; i < 16; ++i) rf[i] = gld<bf16x8>(rq + 32 * (2 + (i >> 3)) * HD, ro, 32 * (i & 7));
            __builtin_amdgcn_sched_barrier(0);
#pragma unroll
            for (int mb = 0; mb < 2; ++mb) {
                if (mb <= (wave & 1)) {
                    f32x16 s;
#pragma unroll
                    for (int r = 0; r < 16; ++r) s[r] = 0.f;
                    { bf16x8 kf[8];
#pragma unroll
                      for (int ks = 0; ks < 8; ++ks) kf[ks] = kfrag(KT, lane, mb, ks);
                      __builtin_amdgcn_sched_barrier(0);
#pragma unroll
                      for (int ks = 0; ks < 8; ++ks) s = __builtin_amdgcn_mfma_f32_32x32x16_bf16(kf[ks], qf[ks], s, 0, 0, 0); }
#pragma unroll
                    for (int r = 0; r < 16; ++r) s[r] = (nloc >= 32 * mb + crow(r, hh)) ? s[r] : 0.f;
                    { bf16x8 vf[8];
#pragma unroll
                      for (int i = 0; i < 8; ++i) vf[i] = vfrag(VT, lane, 32 * mb + 16 * (i >> 2), i & 3);
                      __builtin_amdgcn_sched_barrier(0);
#pragma unroll
                      for (int sp = 0; sp < 2; ++sp) { const bf16x8 pf = pack_frag(s, sp);
#pragma unroll
                          for (int eb = 0; eb < 4; ++eb) O[eb] = __builtin_amdgcn_mfma_f32_32x32x16_bf16(vf[4 * sp + eb], pf, O[eb], 0, 0, 0); } }
                }
            }
#pragma unroll
            for (int i = 0; i < 16; ++i) O[2 + (i >> 3)] = __builtin_amdgcn_mfma_f32_32x32x16_bf16(rf[i], qf[i & 7], O[2 + (i >> 3)], 0, 0, 0);
            const unsigned so = (unsigned)nloc * (ZP * 2) + 8 * hh; f32x4 gn[4][4]; v2u sw[4][4];
#pragma unroll
            for (int eb = 0; eb < 4; ++eb)
#pragma unroll
                for (int rg = 0; rg < 4; ++rg) { gn[eb][rg] = *(const f32x4*)(rgain + 32 * eb + 8 * rg + 4 * hh); sw[eb][rg] = gld<v2u>(zq + 6 * ZS, so, 64 * eb + 16 * rg); }
            __builtin_amdgcn_sched_barrier(0);
            float ss = 0.f;
#pragma unroll
            for (int eb = 0; eb < 4; ++eb)
#pragma unroll
                for (int r = 0; r < 16; ++r) ss += O[eb][r] * O[eb][r];
            const float rstd = 1.0f / sqrtf(swap_sum(ss) * (1.0f / HD) + EPS);
            bf16* yq = YAR + (size_t)M * AW + ((size_t)b * SEQ + cq * CHUNK) * AW + h * HD; const unsigned yo = (unsigned)nloc * (AW * 2) + 8 * hh;
            __builtin_amdgcn_sched_barrier(0);
#pragma unroll
            for (int eb = 0; eb < 4; ++eb)
#pragma unroll
                for (int rg = 0; rg < 4; ++rg) { const f32x4 g4 = gn[eb][rg]; const v2u s2 = sw[eb][rg];
                    const float s0 = __uint_as_float(s2.x << 16), s1 = __uint_as_float(s2.x & 0xffff0000u), s2f = __uint_as_float(s2.y << 16), s3 = __uint_as_float(s2.y & 0xffff0000u);
                    v2u w; w.x = pg8::cvt_pk_bf16(O[eb][4 * rg] * rstd * g4[0] * s0, O[eb][4 * rg + 1] * rstd * g4[1] * s1); w.y = pg8::cvt_pk_bf16(O[eb][4 * rg + 2] * rstd * g4[2] * s2f, O[eb][4 * rg + 3] * rstd * g4[3] * s3);
                    gst<v2u>(yq, yo, 64 * eb + 16 * rg, w); }
        }
        __syncthreads();
        }
    }
}

__device__ __forceinline__ void cast_phase(const float* xs, bf16* XB, float* SSQ, int gw, int NGW, int lane) {
    for (int row = 2 * gw; row < M; row += 2 * NGW) {
        const f32x4* xr = (const f32x4*)(xs + (size_t)row * D_MODEL); f32x4 v[2][8]; float s0 = 0.f, s1 = 0.f;
#pragma unroll
        for (int j = 0; j < 8; ++j) { v[0][j] = xr[lane + 64 * j]; v[1][j] = xr[D_MODEL / 4 + lane + 64 * j]; }
        __builtin_amdgcn_sched_barrier(0);
#pragma unroll
        for (int j = 0; j < 8; ++j) { s0 += (v[0][j].x * v[0][j].x + v[0][j].y * v[0][j].y) + (v[0][j].z * v[0][j].z + v[0][j].w * v[0][j].w); s1 += (v[1][j].x * v[1][j].x + v[1][j].y * v[1][j].y) + (v[1][j].z * v[1][j].z + v[1][j].w * v[1][j].w); }
        const float t0 = wave_sum(s0), t1 = wave_sum(s1);
        v2u* o8 = (v2u*)(XB + (size_t)row * D_MODEL);
#pragma unroll
        for (int j = 0; j < 8; ++j) { v2u o; o.x = pk2(v[0][j].x, v[0][j].y); o.y = pk2(v[0][j].z, v[0][j].w); o8[lane + 64 * j] = o;
            o.x = pk2(v[1][j].x, v[1][j].y); o.y = pk2(v[1][j].z, v[1][j].w); o8[D_MODEL / 4 + lane + 64 * j] = o; }
        SSQ[(size_t)row * 32 + lane] = lane == 0 ? t0 : lane == 32 ? t1 : 0.f;
    }
}
__device__ __forceinline__ void deal_table(LAS int* tab, int Mrows, int Ncols, int G, int bx, int tid) {
    if (tid < 64) { pg8::XcdDeal D; D.init(Mrows, Ncols, G, bx);
#pragma unroll 1
        for (int i = 0; i < 8; ++i) { pg8::Unit u; u.pm = 0; u.pn = 0; const bool ok = D.next(i, u); if (tid == 0) { tab[2 * i] = ok ? u.pm : -1; tab[2 * i + 1] = ok ? u.pn : 0; } }
        if (tid == 0) { tab[16] = D.conv_rank; tab[17] = D.nconv; } }
    __syncthreads();
}
template <class Sched>
__device__ __forceinline__ void rs_prepare(const Sched& S, const float* SSQ, LAS float* rs, int a_rows, int tid) {
    const int t = tid >> 1, hf = tid & 1; f32x4 p[6][4];
#pragma unroll
    for (int ui = 0; ui < 6; ++ui) { pg8::Unit u; u.pm = 0; u.pn = 0; (void)S.next(ui, u);
        int row = (a_rows ? a_rows * u.pm - 2 : 256 * u.pm) + t; row = row < 0 ? 0 : row > M - 1 ? M - 1 : row;
        const f32x4* q = (const f32x4*)(SSQ + (size_t)row * 32 + hf * 16);
#pragma unroll
        for (int k = 0; k < 4; ++k) p[ui][k] = q[k]; }
    __builtin_amdgcn_sched_barrier(0);
#pragma unroll
    for (int ui = 0; ui < 6; ++ui) { const f32x4 a = (p[ui][0] + p[ui][1]) + (p[ui][2] + p[ui][3]); float s = (a.x + a.y) + (a.z + a.w);
        s += __uint_as_float(__builtin_amdgcn_update_dpp(0u, __float_as_uint(s), 0xB1, 0xf, 0xf, true));
        if (!hf) rs[ui * 256 + t] = 1.0f / sqrtf(s * (1.0f / D_MODEL) + EPS); }
    __syncthreads();
}
#define XB_TMO      128
#define XB_XCNT(j)  (256  + 64 * (j))
#define XB_XSUB(j)  (1280 + 64 * (j))
#define XB_XGEN(j)  (2304 + 64 * (j))
#define XB_TOP      3328
#define XB_TOPGEN   3392
#define XCD_BAR_WORDS 3456
#define XB_SPIN_CAP (1u << 18)

__device__ __forceinline__ unsigned xb_ld(unsigned* p)              { return __hip_atomic_load(p, __ATOMIC_RELAXED, __HIP_MEMORY_SCOPE_AGENT); }
__device__ __forceinline__ unsigned xb_add(unsigned* p, unsigned v) { return __hip_atomic_fetch_add(p, v, __ATOMIC_RELAXED, __HIP_MEMORY_SCOPE_AGENT); }
__device__ __forceinline__ unsigned xb_xcc_id() { return (unsigned)__builtin_amdgcn_s_getreg((3 << 11) | 20) & 0xFu; }
#define XB_SPIN(cond, bar) do { unsigned _sp = 0; while (cond) { __builtin_amdgcn_s_sleep(1); \
    if ((++_sp & 255u) == 0u) { if (xb_ld(&(bar)[XB_TMO])) break; if (_sp > XB_SPIN_CAP) { atomicAdd(&(bar)[XB_TMO], 1u); break; } } } } while (0)

struct XcdBarrier {
    unsigned* bar; unsigned x;
    volatile LAS unsigned* st;
    bool t0;
};

__device__ __forceinline__ XcdBarrier xcd_barrier_post(unsigned* bar, volatile LAS unsigned* st) {
    XcdBarrier b; b.bar = bar; b.x = xb_xcc_id(); b.st = st; b.t0 = threadIdx.x == 0;
    if (b.t0) (void)xb_add(&bar[XB_XCNT(b.x)], 1u);
    return b;
}
__device__ __forceinline__ void xcd_barrier_complete(unsigned* bar, unsigned x, unsigned& nloc, unsigned& nx) {
    const unsigned G = gridDim.x * gridDim.y * gridDim.z;
    unsigned sum, cnt, mine, sp = 0u;
    for (;;) {
        sum = 0u; cnt = 0u; mine = 0u;
#pragma unroll
        for (unsigned j = 0; j < 16; ++j) { const unsigned c = xb_ld(&bar[XB_XCNT(j)]); sum += c; cnt += (c > 0u) ? 1u : 0u; mine = (j == x) ? c : mine; }
        if (sum == G) break;
        __builtin_amdgcn_s_sleep(1);
        if ((++sp & 255u) == 0u) { if (xb_ld(&bar[XB_TMO])) break; if (sp > XB_SPIN_CAP) { atomicAdd(&bar[XB_TMO], 1u); break; } }
    }
    nloc = mine > 0u ? mine : 1u; nx = cnt > 0u ? cnt : 1u;
}

__device__ __forceinline__ void xcd_barrier(const XcdBarrier& b) {
    asm volatile("s_waitcnt vmcnt(0)" ::: "memory");
    __syncthreads();
    if (b.t0) {
        unsigned* bar = b.bar;
        __builtin_amdgcn_s_waitcnt(0);
        unsigned nloc = b.st[0], nx = b.st[1];
        if (nloc == 0u) { xcd_barrier_complete(bar, b.x, nloc, nx); b.st[0] = nloc; b.st[1] = nx; }
        const unsigned old = xb_add(&bar[XB_XSUB(b.x)], 1u);
        const unsigned gen = old / nloc;
        if (old + 1u == (gen + 1u) * nloc) {
            __builtin_amdgcn_fence(__ATOMIC_RELEASE, "agent");
            asm volatile("s_waitcnt vmcnt(0)" ::: "memory");
            const unsigned og = xb_add(&bar[XB_TOP], 1u);
            const unsigned tg = og / nx;
            if (og + 1u == (tg + 1u) * nx) xb_add(&bar[XB_TOPGEN], 1u);
            else XB_SPIN(xb_ld(&bar[XB_TOPGEN]) == tg, bar);
            __builtin_amdgcn_fence(__ATOMIC_ACQUIRE, "agent");
            xb_add(&bar[XB_XGEN(b.x)], 1u);
            asm volatile("s_waitcnt vmcnt(0)" ::: "memory");
        } else {
            XB_SPIN(xb_ld(&bar[XB_XGEN(b.x)]) == gen, bar);
            __builtin_amdgcn_fence(__ATOMIC_ACQUIRE, "agent");
            asm volatile("s_waitcnt vmcnt(0)" ::: "memory");
        }
    }
    __syncthreads();
}

#define OPQ_S(x) asm volatile("" : "+s"(x))
#define OPQ_V(x) asm volatile("" : "+v"(x))
#define PHASE_VARS() unsigned char* ws = opq_global(args.ws); int tid = tid_now(wave_s); const int lane = tid & 63, wave = wave_s; \
    const int G = gridDim.x, bx = blockIdx.x, gw = bx * NWAVES + wave, NGW = G * NWAVES; (void)lane; (void)gw; (void)NGW; (void)ws
__global__ void __launch_bounds__(NWAVES * 64, 2) fwd(Args args) {
    extern __shared__ __attribute__((aligned(16))) unsigned char lds_raw[];
    LAS unsigned char* lds = (LAS unsigned char*)lds_raw;
    const int lo = args.ph_lo, hi = args.ph_hi;
#define IN(k) (lo <= (k) && (k) < hi)
#define PHASE_BEGIN(k, REP) if (IN(k)) { PHASE_VARS();
#define PHASE_END(k, REP) if (BOTH(k)) GRID_BAR(); }
#define BOTH(k) (IN(k) && IN((k) + 1))
#define GRID_BAR() do { XcdBarrier b_; b_.t0 = tid_now(wave_s) == 0; b_.bar = (unsigned*)(ws + WS_CTL) + CW_BAR; b_.x = xb_xcc_id(); b_.st = (volatile LAS unsigned*)(lds + MISC_OFF); xcd_barrier(b_); } while (0)
    const int wave_s = __builtin_amdgcn_readfirstlane(threadIdx.x >> 6);
    if (threadIdx.x < 64) ((LAS unsigned*)(lds + MISC_OFF))[threadIdx.x] = 0u;
    __syncthreads();
    deal_table((LAS int*)(lds + TAB_OFF), M, D_IN, gridDim.x, blockIdx.x, threadIdx.x); deal_table((LAS int*)(lds + TAB_OFF + 128), 33 * 256, D_IN, gridDim.x, blockIdx.x, threadIdx.x);
    if (hi - lo > 1) (void)xcd_barrier_post((unsigned*)(args.ws + WS_CTL) + CW_BAR, (volatile LAS unsigned*)(lds + MISC_OFF));

    PHASE_BEGIN(0, 1)
        float* CS = (float*)(ws + WS_CS);
        convert_all(args, ws, 0, CONV_IN_TAILS ? I_IN : DEPTH * I_L, gw, NGW, (LAS float*)(lds + wave * 16640), lane);
#if PROBE_WRITES
        { for (int it = gw; it < DEPTH * I_L; it += NGW) { ConvItem cc = conv_item(args, ws, it);
              const int nblk = cc.N / 64, k0 = 64 * (cc.r / nblk), n0 = 64 * (cc.r % nblk), K = cc.K; const int c = lane & 7;
              const size_t base = ((size_t)((const unsigned char*)cc.WT - (ws + WS_WIN))) & (size_t)(128 * MiB - 1);
#pragma unroll
              for (int j = 0; j < 8; ++j) { const int n = (lane >> 3) + 8 * j; v4u o; o.x = it; o.y = j; o.z = lane; o.w = 0;
                  const size_t off = (base + ((size_t)(n0 + n) * K + k0 + 8 * c) * 2) & (size_t)(128 * MiB - 1);
                  *(v4u*)(ws + WS_ZB + off) = o; } } }
#endif
        cast_phase(GIN(0), (bf16*)(ws + WS_H), (float*)(ws + WS_SSQ), gw, NGW, lane);
        for (int i = bx * 512 + tid; i < SEQ * 64; i += G * 512) { const int pos = i >> 6, k = i & 63; const float inv = powf(10000.0f, -(float)k / 64.0f); const float ang = (float)pos * inv;
            CS[2 * i] = cosf(ang); CS[2 * i + 1] = sinf(ang); }
    PHASE_END(0, 1)

    for (int l = 0; l < DEPTH; ++l) {
        const int pb = 1 + l * NPH;
        PHASE_BEGIN(pb + PH_GEMM1, 1)
            pg8::Gemm g{}; g.wave_s = wave_s; g.A = (const bf16*)(ws + WS_H); g.Bt = (const bf16*)(ws + WS_WIN) + (size_t)l * D_IN * D_MODEL; g.M = M; g.N = D_IN; g.K = D_MODEL;
            pg8::ListOrder S; S.tab = (LAS const int*)(lds + TAB_OFF);
#pragma unroll 1
            for (int rep_ = 0; rep_ < REP_G1; ++rep_) {
            if (rep_) __syncthreads();
            rs_prepare(S, (const float*)(ws + WS_SSQ), (LAS float*)(lds + RS_OFF), 0, tid);
            pg8::Epi1 E; E.rs = (LAS const float*)(lds + RS_OFF); E.ZB = (bf16*)(ws + WS_ZB); E.qg = GIN(5) + l * HD; E.kg = GIN(6) + l * HD; E.cs = (const float*)(ws + WS_CS); E.xch = (LAS float*)(lds + XCH_OFF);
            if (CONV_IN_TAILS) { const int cr = __builtin_amdgcn_readfirstlane(S.tab[16]), nc = __builtin_amdgcn_readfirstlane(S.tab[17]);
                if (cr >= 0) convert_all(args, ws, l * I_L + I_IN, l * I_L + I_IN + I_BR + I_O + I_UP, cr * NWAVES + wave, nc * NWAVES, (LAS float*)(lds + wave * 16640), lane);
                __syncthreads(); }
            pg8::gemm_phase<pg8::Epi1, pg8::ListOrder, true, true>(lds + RING_OFF, g, S, E);
            }
            PHASE_END(pb + PH_GEMM1, 1)
        PHASE_BEGIN(pb + PH_MIX, 1)
            state_phase(lds, ws, (unsigned)(l + 1), bx, G, tid);
            { unsigned char* ws2 = opq_global(args.ws); int tid2 = tid_now(wave_s); mix_phase(lds, ws2, (unsigned)(l + 1), GIN(7), GIN(8) + l * HD, bx, G, tid2); }
            PHASE_END(pb + PH_MIX, 1)
        PHASE_BEGIN(pb + PH_BR, 1)
            pg8::Gemm g{}; g.wave_s = wave_s; g.A = (const bf16*)(ws + WS_YAR); g.Bt = (const bf16*)(ws + WS_WBR) + (size_t)(2 * l) * D_MODEL * AW; g.M = 2 * M; g.N = 2 * D_MODEL; g.K = AW;
            pg8::BranchOrder S; S.init(G, bx);
            pg8::EpiBr E; E.ZB = (const bf16*)(ws + WS_ZB); E.MRG = (bf16*)(ws + WS_MRG);
            pg8::gemm_phase<pg8::EpiBr, pg8::BranchOrder, true, true>(lds + RING_OFF, g, S, E);
            PHASE_END(pb + PH_BR, 1)
        PHASE_BEGIN(pb + PH_WO, 1)
            pg8::Gemm g{}; g.wave_s = wave_s; g.A = (const bf16*)(ws + WS_MRG); g.Bt = (const bf16*)(ws + WS_WO) + (size_t)l * D_MODEL * D_MODEL; g.M = M; g.N = D_MODEL; g.K = D_MODEL;
            pg8::StaticOrder S; S.init(M, D_MODEL, G, bx);
            pg8::EpiRes E; E.x32 = l == 0 ? GIN(0) : nullptr; E.out32 = nullptr; E.XB = (bf16*)(ws + WS_H); E.SSQ = (float*)(ws + WS_SSQ);
            pg8::gemm_phase<pg8::EpiRes, pg8::StaticOrder, true, true>(lds + RING_OFF, g, S, E);
            PHASE_END(pb + PH_WO, 1)
        PHASE_BEGIN(pb + PH_UP, 1)
            pg8::Gemm g{}; g.wave_s = wave_s; g.A = (const bf16*)(ws + WS_H) - 2 * D_MODEL; g.Bt = (const bf16*)(ws + WS_WUP) + (size_t)l * D_IN * D_MODEL; g.M = 33 * 256; g.N = D_IN; g.K = D_MODEL; g.a_rows = 254;
            pg8::ListOrder S; S.tab = (LAS const int*)(lds + TAB_OFF + 128);
#pragma unroll 1
            for (int rep_ = 0; rep_ < REP_UP; ++rep_) {
            if (rep_) __syncthreads();
            rs_prepare(S, (const float*)(ws + WS_SSQ), (LAS float*)(lds + RS_OFF), 254, tid);
            pg8::EpiUC E; E.rs = (LAS const float*)(lds + RS_OFF); E.ACT = (bf16*)(ws + WS_ACT); E.cw = GIN(11) + (size_t)l * 3 * 2 * D_FF; E.cb = GIN(12) + (size_t)l * 2 * D_FF; E.xch = (LAS float*)(lds + XCH_OFF);
            if (CONV_IN_TAILS) { const int cr = __builtin_amdgcn_readfirstlane(S.tab[16]), nc = __builtin_amdgcn_readfirstlane(S.tab[17]);
                if (cr >= 0) convert_all(args, ws, l * I_L + I_IN + I_BR + I_O + I_UP, l + 1 < DEPTH ? (l + 1) * I_L + I_IN : (l + 1) * I_L, cr * NWAVES + wave, nc * NWAVES, (LAS float*)(lds + wave * 16640), lane);
                __syncthreads(); }
            pg8::gemm_phase<pg8::EpiUC, pg8::ListOrder, true, true>(lds + RING_OFF, g, S, E);
            }
            PHASE_END(pb + PH_UP, 1)
        PHASE_BEGIN(pb + PH_DOWN, 1)
            pg8::Gemm g{}; g.wave_s = wave_s; g.A = (const bf16*)(ws + WS_ACT); g.Bt = (const bf16*)(ws + WS_WDN) + (size_t)l * D_MODEL * D_FF; g.M = M; g.N = D_MODEL; g.K = D_FF;
            pg8::StaticOrder S; S.init(M, D_MODEL, G, bx);
            pg8::EpiRes E; E.x32 = nullptr; E.out32 = (l == DEPTH - 1) ? args.out : nullptr; E.XB = (bf16*)(ws + WS_H); E.SSQ = (float*)(ws + WS_SSQ);
            pg8::gemm_phase<pg8::EpiRes, pg8::StaticOrder, true, true>(lds + RING_OFF, g, S, E);
            PHASE_END(pb + PH_DOWN, 1)
    }
#undef IN
#undef BOTH
}

extern "C" void kernel_launch(void* const* d_in, const int* in_sizes, int n_in, void* d_out, int out_size, void* d_ws, size_t ws_size, hipStream_t stream) {
    static int grid = 0;
    if (grid == 0) {
        if (n_in != 14 || ws_size < WS_END || out_size != M * D_MODEL) { fprintf(stderr, "kernel_launch: bad inputs (n_in %d, ws %zu < %zu, out %d)\n", n_in, ws_size, (size_t)WS_END, out_size); grid = -1; return; }
        int dev = 0, cus = 0;
        if (hipGetDevice(&dev) != hipSuccess || hipDeviceGetAttribute(&cus, hipDeviceAttributeMultiprocessorCount, dev) != hipSuccess) { grid = -1; return; }
        if (hipFuncSetAttribute((const void*)fwd, hipFuncAttributeMaxDynamicSharedMemorySize, LDS_BYTES) != hipSuccess) { fprintf(stderr, "kernel_launch: hipFuncSetAttribute failed\n"); grid = -1; return; }
        cus -= cus % 8;
        if (cus < 242) { fprintf(stderr, "kernel_launch: %d usable CUs < 242 (the rstd table holds 6 units per workgroup)\n", cus); grid = -1; return; }
        grid = cus;
    }
    if (grid < 0) return;
    (void)hipMemsetAsync((char*)d_ws + WS_CTL, 0, CTL_ZERO_BYTES, stream);
    Args a{};
    for (int i = 0; i < 14; ++i) a.in[i] = (const float*)d_in[i];
    a.out = (float*)d_out; a.ws = (unsigned char*)d_ws;
    if (ONE_LAUNCH) { a.ph_lo = 0; a.ph_hi = N_PHASES; hipLaunchKernelGGL(fwd, dim3(grid), dim3(NWAVES * 64), LDS_BYTES, stream, a); }
    else for (int ph = 0; ph < N_PHASES; ++ph) { const int nrep = (ph > 0 && (ph - 1) % NPH == PROBE_PH) ? PROBE_N : 1;
        for (int r = 0; r < nrep; ++r) { a.ph_lo = ph; a.ph_hi = ph + 1; hipLaunchKernelGGL(fwd, dim3(grid), dim3(NWAVES * 64), LDS_BYTES, stream, a); } }
}
```
